# Optimizing an MI355X kernel written in HIP

```python
import jax
import jax.numpy as jnp
from jax import lax
import numpy as np

D_MODEL = 2048
BATCH = 8
SEQ = 4096
DEPTH = 1

HEAD_DIM = 128
M_WIDTH = D_MODEL // 4
A_WIDTH = (D_MODEL - M_WIDTH) // 2
B_WIDTH = D_MODEL - M_WIDTH - A_WIDTH
M_HEADS = M_WIDTH // HEAD_DIM
A_GROUPS = A_WIDTH // HEAD_DIM
B_HEADS = B_WIDTH // HEAD_DIM
D_PROJ = 2 * A_WIDTH + 3 * B_WIDTH + M_WIDTH
CHUNK = 128
DILATED_PATTERNS = ((128, 1), (512, 4), (2048, 16))
ATT_BLOCK = 128
N_MEM = 256
N_EXPERTS = 32
TOP_K = 4
D_FF = D_MODEL
SWIGLU_LIMIT = 7.0
SWIGLU_ALPHA = 1.702
MOE_BLOCK = 512
LN_EPS = 1e-5
NEG_INF = -1e30
DN_ALPHA = (2.0 * DEPTH) ** 0.25
DN_BETA = (8.0 * DEPTH) ** -0.25

kernel_name = "hymba_gmlp_longnet_mem_moe_deepnorm"


def layer_norm(x, g, b):
    xf = x.astype(jnp.float32)
    mu = jnp.mean(xf, axis=-1, keepdims=True)
    var = jnp.mean(jnp.square(xf - mu), axis=-1, keepdims=True)
    return ((xf - mu) * lax.rsqrt(var + LN_EPS)).astype(x.dtype) * g + b


def rms_norm(x, g):
    xf = x.astype(jnp.float32)
    return (xf * lax.rsqrt(jnp.mean(jnp.square(xf), axis=-1, keepdims=True) + LN_EPS)).astype(x.dtype) * g


def chunked_spatial_gating(a, w_spatial, b_spatial, ln_g, ln_b):
    bsz, seq, _ = a.shape
    u, v = jnp.split(a, 2, axis=-1)
    v = layer_norm(v, ln_g, ln_b)
    v = v.reshape(bsz, seq // CHUNK, CHUNK, A_GROUPS, HEAD_DIM)
    causal = jnp.tril(jnp.ones((CHUNK, CHUNK), dtype=bool))
    w = jnp.where(causal[None], w_spatial, 0)
    mixed = jnp.einsum('gts,bnsgc->bntgc', w, v) + b_spatial.T[None, None, :, :, None]
    return u * mixed.reshape(bsz, seq, A_WIDTH)


def dilated_window_attention(q, k, v, window, dilation):
    bsz, seq, nh, dh = q.shape
    span = window // dilation
    sub_len = seq // dilation
    nb = -(-sub_len // ATT_BLOCK)
    lp = nb * ATT_BLOCK

    def to_sub(t):
        t = t.reshape(bsz, sub_len, dilation, nh, dh).transpose(0, 2, 1, 3, 4)
        return jnp.pad(t, ((0, 0), (0, 0), (0, lp - sub_len), (0, 0), (0, 0)))

    def windowed(t):
        prev = jnp.pad(t, ((0, 0), (0, 0), (ATT_BLOCK, 0), (0, 0), (0, 0)))[:, :, :lp]
        prev = prev.reshape(bsz, dilation, nb, ATT_BLOCK, nh, dh)
        cur = t.reshape(bsz, dilation, nb, ATT_BLOCK, nh, dh)
        return jnp.concatenate([prev, cur], axis=3)

    qb = to_sub(q).reshape(bsz, dilation, nb, ATT_BLOCK, nh, dh)
    kw = windowed(to_sub(k))
    vw = windowed(to_sub(v))
    s = jnp.einsum('brnqhc,brnkhc->brnhqk', qb, kw,
                   preferred_element_type=jnp.float32) * (HEAD_DIM ** -0.5)
    qi = jnp.arange(ATT_BLOCK)[:, None]
    kj = jnp.arange(2 * ATT_BLOCK)[None, :]
    dist = qi + ATT_BLOCK - kj
    key_pos = jnp.arange(nb)[:, None, None] * ATT_BLOCK - ATT_BLOCK + kj[None]
    mask = (dist >= 0) & (dist <= span) & (key_pos >= 0)
    s = jnp.where(mask[None, None, :, None], s, NEG_INF)
    lse = jax.nn.logsumexp(s, axis=-1)
    p = jnp.exp(s - lse[..., None])
    o = jnp.einsum('brnhqk,brnkhc->brnqhc', p.astype(v.dtype), vw)

    def from_sub(t):
        t = jnp.moveaxis(t[:, :, :sub_len], 1, 2)
        return t.reshape(bsz, seq, *t.shape[3:])

    o = from_sub(o.reshape(bsz, dilation, lp, nh, dh))
    lse = from_sub(lse.transpose(0, 1, 2, 4, 3).reshape(bsz, dilation, lp, nh))
    return o, lse


def dilated_mixture_attention(q, k, v):
    outs, lses = [], []
    for window, dilation in DILATED_PATTERNS:
        o, lse = dilated_window_attention(q, k, v, window, dilation)
        outs.append(o)
        lses.append(lse)
    wts = jax.nn.softmax(jnp.stack(lses, axis=0), axis=0)
    o = jnp.einsum('pbsh,pbshc->bshc', wts, jnp.stack(outs, axis=0).astype(jnp.float32))
    return o.astype(q.dtype)


def memory_cross_attention(q, mem, w_mem_kv):
    bsz, n_mem, _ = mem.shape
    kv = (mem @ w_mem_kv).reshape(bsz, n_mem, 2, M_HEADS, HEAD_DIM)
    k, v = kv[:, :, 0], kv[:, :, 1]
    s = jnp.einsum('bshc,bmhc->bhsm', q, k, preferred_element_type=jnp.float32) * (HEAD_DIM ** -0.5)
    p = jax.nn.softmax(s, axis=-1)
    return jnp.einsum('bhsm,bmhc->bshc', p.astype(v.dtype), v)


def mixing_sublayer(x, mem, w_in, w_spatial, b_spatial, a_ln_g, a_ln_b, w_mem_kv,
                    norm_a_g, norm_b_g, norm_m_g, w_out):
    bsz, seq, _ = x.shape
    z = x @ w_in
    o1 = 2 * A_WIDTH
    za, zq, zk, zv, zm = jnp.split(z, [o1, o1 + B_WIDTH, o1 + 2 * B_WIDTH, o1 + 3 * B_WIDTH], axis=-1)
    y_a = chunked_spatial_gating(jax.nn.gelu(za), w_spatial, b_spatial, a_ln_g, a_ln_b)
    heads = lambda t, h: t.reshape(bsz, seq, h, HEAD_DIM)
    y_b = dilated_mixture_attention(heads(zq, B_HEADS), heads(zk, B_HEADS), heads(zv, B_HEADS))
    y_m = memory_cross_attention(heads(zm, M_HEADS), mem, w_mem_kv)
    y = jnp.concatenate([rms_norm(y_a, norm_a_g),
                         rms_norm(y_b.reshape(bsz, seq, B_WIDTH), norm_b_g),
                         rms_norm(y_m.reshape(bsz, seq, M_WIDTH), norm_m_g)], axis=-1)
    return y @ w_out


def moe_ffn(h, w_router, b_router, w_gate_up, b_gate_up, w_down, b_down):
    bsz, seq, d = h.shape
    n_tok = bsz * seq
    hf = h.reshape(n_tok, d)
    logits = (hf @ w_router + b_router).astype(jnp.float32)
    top_val, top_idx = lax.top_k(logits, TOP_K)
    gates = jax.nn.softmax(top_val, axis=-1).astype(h.dtype)
    n_assign = n_tok * TOP_K
    flat_e = top_idx.reshape(-1)
    flat_tok = jnp.arange(n_assign, dtype=jnp.int32) // TOP_K
    flat_g = gates.reshape(-1)
    order = jnp.argsort(flat_e)
    sorted_e = flat_e[order]
    counts = jnp.bincount(flat_e, length=N_EXPERTS)
    padded = (counts + MOE_BLOCK - 1) // MOE_BLOCK * MOE_BLOCK
    start = jnp.cumsum(counts) - counts
    pad_end = jnp.cumsum(padded)
    pad_start = pad_end - padded
    rank = jnp.arange(n_assign, dtype=jnp.int32) - start[sorted_e]
    dest = pad_start[sorted_e] + rank
    n_blocks = (n_assign + N_EXPERTS * (MOE_BLOCK - 1)) // MOE_BLOCK + 1
    n_rows = n_blocks * MOE_BLOCK
    row_tok = jnp.zeros((n_rows,), jnp.int32).at[dest].set(flat_tok[order])
    row_gate = jnp.zeros((n_rows,), h.dtype).at[dest].set(flat_g[order])
    block_expert = jnp.minimum(
        jnp.searchsorted(pad_end, jnp.arange(n_blocks, dtype=jnp.int32) * MOE_BLOCK, side='right'),
        N_EXPERTS - 1)
    xs = hf[row_tok].reshape(n_blocks, MOE_BLOCK, d)

    def expert_block(args):
        xb, e = args
        gu = xb @ w_gate_up[e] + b_gate_up[e]
        gate, up = jnp.split(gu, 2, axis=-1)
        gate = jnp.minimum(gate, SWIGLU_LIMIT)
        up = jnp.clip(up, -SWIGLU_LIMIT, SWIGLU_LIMIT)
        act = (up + 1.0) * (gate * jax.nn.sigmoid(SWIGLU_ALPHA * gate))
        return act @ w_down[e] + b_down[e]

    ys = lax.map(expert_block, (xs, block_expert)).reshape(n_rows, d) * row_gate[:, None]
    out = jax.ops.segment_sum(ys, row_tok, num_segments=n_tok)
    return out.reshape(bsz, seq, d)


def setup_inputs(seed: int = 0) -> dict:
    key = jax.random.key(seed)
    ks = jax.random.split(key, 22)
    nrm = lambda k, shape, scale: jax.random.normal(k, shape, jnp.float32) * scale
    L = DEPTH
    return {
        "x": nrm(ks[0], (BATCH, SEQ, D_MODEL), 1.0),
        "mem": nrm(ks[1], (BATCH, N_MEM, D_MODEL), 1.0),
        "w_in": nrm(ks[2], (L, D_MODEL, D_PROJ), D_MODEL ** -0.5),
        "w_spatial": nrm(ks[3], (L, A_GROUPS, CHUNK, CHUNK), CHUNK ** -0.5),
        "b_spatial": 1.0 + nrm(ks[4], (L, A_GROUPS, CHUNK), 0.1),
        "a_ln_g": 1.0 + nrm(ks[5], (L, A_WIDTH), 0.02),
        "a_ln_b": nrm(ks[6], (L, A_WIDTH), 0.02),
        "w_mem_kv": nrm(ks[7], (L, D_MODEL, 2 * M_WIDTH), D_MODEL ** -0.5),
        "norm_a_g": 1.0 + nrm(ks[8], (L, A_WIDTH), 0.02),
        "norm_b_g": 1.0 + nrm(ks[9], (L, B_WIDTH), 0.02),
        "norm_m_g": 1.0 + nrm(ks[10], (L, M_WIDTH), 0.02),
        "w_out": nrm(ks[11], (L, D_MODEL, D_MODEL), D_MODEL ** -0.5 * DN_BETA),
        "ln1_g": 1.0 + nrm(ks[12], (L, D_MODEL), 0.02),
        "ln1_b": nrm(ks[13], (L, D_MODEL), 0.02),
        "w_router": nrm(ks[14], (L, D_MODEL, N_EXPERTS), D_MODEL ** -0.5),
        "b_router": nrm(ks[15], (L, N_EXPERTS), 0.01),
        "w_gate_up": nrm(ks[16], (L, N_EXPERTS, D_MODEL, 2 * D_FF), D_MODEL ** -0.5),
        "b_gate_up": nrm(ks[17], (L, N_EXPERTS, 2 * D_FF), 0.01),
        "w_down": nrm(ks[18], (L, N_EXPERTS, D_FF, D_MODEL), D_FF ** -0.5 * DN_BETA),
        "b_down": nrm(ks[19], (L, N_EXPERTS, D_MODEL), 0.01),
        "ln2_g": 1.0 + nrm(ks[20], (L, D_MODEL), 0.02),
        "ln2_b": nrm(ks[21], (L, D_MODEL), 0.02),
    }


def reference(x, mem, w_in, w_spatial, b_spatial, a_ln_g, a_ln_b, w_mem_kv,
              norm_a_g, norm_b_g, norm_m_g, w_out, ln1_g, ln1_b,
              w_router, b_router, w_gate_up, b_gate_up, w_down, b_down, ln2_g, ln2_b):
    for l in range(DEPTH):
        mix = mixing_sublayer(x, mem, w_in[l], w_spatial[l], b_spatial[l], a_ln_g[l], a_ln_b[l],
                              w_mem_kv[l], norm_a_g[l], norm_b_g[l], norm_m_g[l], w_out[l])
        x = layer_norm(DN_ALPHA * x + mix, ln1_g[l], ln1_b[l])
        ffn = moe_ffn(x, w_router[l], b_router[l], w_gate_up[l], b_gate_up[l], w_down[l], b_down[l])
        x = layer_norm(DN_ALPHA * x + ffn, ln2_g[l], ln2_b[l])
    return x
```

```cpp
#include <hip/hip_runtime.h>
#include <cstdio>
#include <cstdint>
#ifndef ONE_LAUNCH
#define ONE_LAUNCH 1
#endif
#ifndef MOE_RT8
#define MOE_RT8 4
#endif
#ifndef BF16_SP2
#define BF16_SP2 true
#endif
namespace pg8 {
#define PG8_LAS __attribute__((address_space(3)))
typedef unsigned short bf16_t;
typedef short bf16x8 __attribute__((ext_vector_type(8)));
typedef float f32x4 __attribute__((ext_vector_type(4)));
typedef unsigned u32x4 __attribute__((ext_vector_type(4)));
typedef int i32x4 __attribute__((ext_vector_type(4)));
typedef unsigned u32x2 __attribute__((ext_vector_type(2)));
constexpr int BM = 256, BK = 64, HALF = 128, HTB = HALF * BK * 2  , STAGE_BYTES = 8 * HTB, NXCD = 8, WGM = 8;

__host__ __device__ __forceinline__ int lds_byte(int r, int c) { const int st = (r >> 4) * 2 + (c >> 5), rr = r & 15, cc = c & 31, ob = rr * 64 + cc * 2; return st * 1024 + (ob ^ (((ob >> 9) & 1) << 5)); }
__host__ __device__ __forceinline__ void stage_rc(int b, int& R, int& C) { const int st = b / 1024, sb = b % 1024, swz = sb ^ (((sb >> 9) & 1) << 5); R = (st >> 1) * 16 + swz / 64; C = (st & 1) * 32 + (swz % 64) / 2; }
__host__ __device__ __forceinline__ int perm32(int rho) { const int n = rho >> 4, i = rho & 15; return 8 * (i >> 2) + 4 * n + (i & 3); }

struct Unit { int pm, pn; };
struct Gemm { const bf16_t* A; const bf16_t* Bt; int M, N, K; };

struct StaticOrder {
    int nM, nN, nwg, G, c;
    __host__ __device__ void init(int M, int N, int G_, int c_) { nM = M / BM; nN = N / BM; nwg = nM * nN; G = G_; c = c_; }
    __host__ __device__ bool next(int i, Unit& u) const {
        const long L = (long)i * G + c; if (L >= nwg) return false;
        int wgid = (int)L; { const int q = nwg / NXCD, r = nwg % NXCD, xcd = wgid % NXCD, off = wgid / NXCD; wgid = (xcd < r ? xcd * (q + 1) : r * (q + 1) + (xcd - r) * q) + off; }
        const int nig = WGM * nN, gid = wgid / nig, fm = gid * WGM, gsz = (nM - fm) < WGM ? (nM - fm) : WGM;
        u.pm = fm + ((wgid % nig) % gsz); u.pn = (wgid % nig) / gsz; return true;
    }
    __device__ __forceinline__ void a_ready(const Unit&) const {}
    __device__ __forceinline__ void done(const Unit&) const {}
};
__device__ __forceinline__ unsigned cvt_pk_bf16(float lo, float hi) { unsigned r; asm volatile("v_cvt_pk_bf16_f32 %0, %1, %2" : "=v"(r) : "v"(lo), "v"(hi)); return r; }
typedef float f32x2 __attribute__((ext_vector_type(2)));
__device__ __forceinline__ float gelu_tanh(float x) {
    const float u = x * (1.0f + 0.044715f * x * x);
    const float e = __builtin_amdgcn_exp2f(u * -2.302208198f);
    return x * __builtin_amdgcn_rcpf(1.0f + e);
}
__device__ __forceinline__ float swiglu_act(float gate, float up) {
    const float g = fminf(gate, 7.0f), u = fminf(fmaxf(up, -7.0f), 7.0f);
    const float e = __builtin_amdgcn_exp2f(g * -2.455466959f);
    return (u + 1.0f) * g * __builtin_amdgcn_rcpf(1.0f + e);
}
__device__ __forceinline__ f32x2 gelu_tanh_pk(f32x2 x) {
    const f32x2 t = (x * x) * (-2.302208198f * 0.044715f) + (-2.302208198f), z = x * t;
    f32x2 ex; ex.x = __builtin_amdgcn_exp2f(z.x); ex.y = __builtin_amdgcn_exp2f(z.y);
    const f32x2 d = ex + 1.0f; f32x2 r; r.x = __builtin_amdgcn_rcpf(d.x); r.y = __builtin_amdgcn_rcpf(d.y);
    return x * r;
}
__device__ __forceinline__ f32x2 swiglu_pk(f32x2 gate, f32x2 up, float oscale) {
    const f32x2 g = __builtin_elementwise_min(gate, (f32x2){7.0f, 7.0f}), u = __builtin_elementwise_min(__builtin_elementwise_max(up, (f32x2){-7.0f, -7.0f}), (f32x2){7.0f, 7.0f});
    const f32x2 z = g * -2.455466959f; f32x2 ex; ex.x = __builtin_amdgcn_exp2f(z.x); ex.y = __builtin_amdgcn_exp2f(z.y);
    const f32x2 d = ex + 1.0f; f32x2 r; r.x = __builtin_amdgcn_rcpf(d.x); r.y = __builtin_amdgcn_rcpf(d.y);
    return (u * oscale + oscale) * (g * r);
}
struct EpiZ {
    static constexpr bool PERM = true, AFTER_DRAIN = false;
    bf16_t* O; int ldc; int nact;
    __device__ __forceinline__ void operator()(const f32x4 (&acc)[2][2][4][2], const Unit& u, int wr, int wc, int fr, int fq) const {
        const int row0 = u.pm * BM + wr * 64 + fr, col0 = u.pn * BM + wc * 32 + 8 * fq; const bool act = u.pn < nact;
#pragma unroll
        for (int ai = 0; ai < 2; ++ai)
#pragma unroll
            for (int m = 0; m < 4; ++m) { bf16_t* rowp = O + (size_t)(row0 + ai * HALF + m * 16) * ldc + col0;
#pragma unroll
                for (int bj = 0; bj < 2; ++bj) { f32x4 v0 = acc[ai][bj][m][0], v1 = acc[ai][bj][m][1];
                    if (act) {
#pragma unroll
                        for (int j = 0; j < 1; ++j) { const f32x2 a0 = gelu_tanh_pk((f32x2){v0[0], v0[1]}), a1 = gelu_tanh_pk((f32x2){v0[2], v0[3]}), b0 = gelu_tanh_pk((f32x2){v1[0], v1[1]}), b1 = gelu_tanh_pk((f32x2){v1[2], v1[3]});
                            v0 = (f32x4){a0.x, a0.y, a1.x, a1.y}; v1 = (f32x4){b0.x, b0.y, b1.x, b1.y}; } }
                    u32x4 w; w.x = cvt_pk_bf16(v0[0], v0[1]); w.y = cvt_pk_bf16(v0[2], v0[3]); w.z = cvt_pk_bf16(v1[0], v1[1]); w.w = cvt_pk_bf16(v1[2], v1[3]);
                    *(u32x4*)(rowp + bj * HALF) = w; } }
    }
};
struct EpiRes {
    static constexpr bool PERM = true, AFTER_DRAIN = false;
    const bf16_t* X; bf16_t* H; int ldc; float alpha;
    __device__ __forceinline__ void operator()(const f32x4 (&acc)[2][2][4][2], const Unit& u, int wr, int wc, int fr, int fq) const {
        const int row0 = u.pm * BM + wr * 64 + fr, col0 = u.pn * BM + wc * 32 + 8 * fq;
        u32x4 xr[2][4][2];
#pragma unroll
        for (int ai = 0; ai < 2; ++ai)
#pragma unroll
            for (int m = 0; m < 4; ++m)
#pragma unroll
                for (int bj = 0; bj < 2; ++bj) xr[ai][m][bj] = *(const u32x4*)(X + (size_t)(row0 + ai * HALF + m * 16) * ldc + col0 + bj * HALF);
        asm volatile("" ::: "memory");
#pragma unroll
        for (int ai = 0; ai < 2; ++ai)
#pragma unroll
            for (int m = 0; m < 4; ++m) { const size_t off = (size_t)(row0 + ai * HALF + m * 16) * ldc + col0;
#pragma unroll
                for (int bj = 0; bj < 2; ++bj) { const u32x4 xw = xr[ai][m][bj]; const f32x4 a0 = acc[ai][bj][m][0], a1 = acc[ai][bj][m][1];
                    u32x4 w; w.x = cvt_pk_bf16(__uint_as_float(xw.x << 16) * alpha + a0[0], __uint_as_float(xw.x & 0xffff0000u) * alpha + a0[1]); w.y = cvt_pk_bf16(__uint_as_float(xw.y << 16) * alpha + a0[2], __uint_as_float(xw.y & 0xffff0000u) * alpha + a0[3]);
                    w.z = cvt_pk_bf16(__uint_as_float(xw.z << 16) * alpha + a1[0], __uint_as_float(xw.z & 0xffff0000u) * alpha + a1[1]); w.w = cvt_pk_bf16(__uint_as_float(xw.w << 16) * alpha + a1[2], __uint_as_float(xw.w & 0xffff0000u) * alpha + a1[3]);
                    *(u32x4*)(H + off + bj * HALF) = w; } }
    }
};
__device__ __forceinline__ unsigned pk4_fp8e(float a, float b, float c, float d) { int r = __builtin_amdgcn_cvt_pk_fp8_f32(a, b, 0, false); r = __builtin_amdgcn_cvt_pk_fp8_f32(c, d, r, true); return (unsigned)r; }
struct EpiGU {
    static constexpr bool PERM = true, AFTER_DRAIN = false;
    unsigned char* ACT; const float* bgu; float ascale, oscale;
    __device__ __forceinline__ void operator()(const f32x4 (&acc)[2][2][4][2], const Unit& u, int wr, int wc, int fr, int fq, const PG8_LAS unsigned char* ut) const {
        const int pnl = u.pn & 15; const int row0 = u.pm * BM + wr * 64 + fr, cl = pnl * 128 + wc * 32 + 8 * fq;
        const PG8_LAS float* bg = (const PG8_LAS float*)(ut + 1024) + wc * 32 + 8 * fq; const PG8_LAS float* bu = bg + 128;
        const f32x4 g0 = *(const PG8_LAS f32x4*)bg, g1 = *(const PG8_LAS f32x4*)(bg + 4), u0 = *(const PG8_LAS f32x4*)bu, u1 = *(const PG8_LAS f32x4*)(bu + 4);
#pragma unroll
        for (int ai = 0; ai < 2; ++ai)
#pragma unroll
            for (int m = 0; m < 4; ++m) { unsigned char* rowp = ACT + (size_t)(row0 + ai * HALF + m * 16) * 2048 + cl;
                const f32x4 ga = acc[ai][0][m][0] * ascale + g0, gb = acc[ai][0][m][1] * ascale + g1, ua = acc[ai][1][m][0] * ascale + u0, ub = acc[ai][1][m][1] * ascale + u1;
                f32x4 ra, rb;
#pragma unroll
                for (int j = 0; j < 1; ++j) { const f32x2 a0 = swiglu_pk((f32x2){ga[0], ga[1]}, (f32x2){ua[0], ua[1]}, oscale), a1 = swiglu_pk((f32x2){ga[2], ga[3]}, (f32x2){ua[2], ua[3]}, oscale), b0 = swiglu_pk((f32x2){gb[0], gb[1]}, (f32x2){ub[0], ub[1]}, oscale), b1 = swiglu_pk((f32x2){gb[2], gb[3]}, (f32x2){ub[2], ub[3]}, oscale);
                    ra = (f32x4){a0.x, a0.y, a1.x, a1.y}; rb = (f32x4){b0.x, b0.y, b1.x, b1.y}; }
                u32x2 w; w.x = pk4_fp8e(ra[0], ra[1], ra[2], ra[3]); w.y = pk4_fp8e(rb[0], rb[1], rb[2], rb[3]);
                *(u32x2*)rowp = w; }
    }
};
struct EpiDown {
    static constexpr bool PERM = true, AFTER_DRAIN = false;
    unsigned char* YS; const float* bd; const float* rowgate; float ascale, oscale;
    __device__ __forceinline__ void operator()(const f32x4 (&acc)[2][2][4][2], const Unit& u, int wr, int wc, int fr, int fq, const PG8_LAS unsigned char* ut) const {
        const int pnl = u.pn & 7; const int row0 = u.pm * BM + wr * 64 + fr, col0 = pnl * BM + wc * 32 + 8 * fq;
        f32x4 bv[2][2]; const PG8_LAS float* bl = (const PG8_LAS float*)(ut + 1024) + wc * 32 + 8 * fq; const PG8_LAS float* gl = (const PG8_LAS float*)ut + wr * 64 + fr;
#pragma unroll
        for (int bj = 0; bj < 2; ++bj)
#pragma unroll
            for (int n = 0; n < 2; ++n) bv[bj][n] = *(const PG8_LAS f32x4*)(bl + bj * HALF + 4 * n);
#pragma unroll
        for (int ai = 0; ai < 2; ++ai)
#pragma unroll
            for (int m = 0; m < 4; ++m) { const int r = row0 + ai * HALF + m * 16; const float gt = gl[ai * HALF + m * 16] * oscale; unsigned char* rowp = YS + (size_t)r * 2048 + col0;
#pragma unroll
                for (int bj = 0; bj < 2; ++bj) { const f32x4 v0 = (acc[ai][bj][m][0] * ascale + bv[bj][0]) * gt, v1 = (acc[ai][bj][m][1] * ascale + bv[bj][1]) * gt;
                    u32x2 w; w.x = pk4_fp8e(v0[0], v0[1], v0[2], v0[3]); w.y = pk4_fp8e(v1[0], v1[1], v1[2], v1[3]);
                    *(u32x2*)(rowp + bj * HALF) = w; } }
    }
};
struct MoeOrder {
    const PG8_LAS int* tb; int sh, G, c, total, hot; PG8_LAS unsigned char* utab; const char* tabA; const float* bias;
    __device__ __forceinline__ void srcs(const Unit& u, int lane, const char*& sa, const char*& sb) const {
        sa = tabA + ((size_t)u.pm * 256 + lane * 4) * 4;
        if (sh == 4) { const float* b0 = bias + (size_t)(u.pn >> 4) * 4096 + (u.pn & 15) * 128; sb = (const char*)(lane < 32 ? b0 + lane * 4 : b0 + 2048 + (lane - 32) * 4); }
        else sb = (const char*)(bias + (size_t)(u.pn >> 3) * 2048 + (u.pn & 7) * 256 + lane * 4);
    }
    __device__ __forceinline__ bool next(int i, Unit& u) const {
        const long L = (long)i * G + c; if (!(sh == 3 && G == 256) && L >= total) return false;
        if (hot) { u.pm = (int)(L & 7); u.pn = (int)((L >> 3) & 3); return true; }
        int mtg = (int)(L >> sh), pn = (int)L & ((1 << sh) - 1);
        if (sh == 3 && G == 256) {
            const int RT = MOE_RT8, CT = 32 / RT, NCG = (1 << sh) / CT;
            const int s = i * 8 + (c & 7), j = c >> 3; const int rg = s / NCG, cg = s % NCG;
            mtg = rg * RT + (j % RT); pn = cg * CT + j / RT; if (mtg >= tb[32]) return false; }
        int e = 0;
#pragma unroll
        for (int j = 1; j < 32; ++j) e += (tb[j] <= mtg) ? 1 : 0;
        u.pm = mtg; u.pn = (e << sh) + pn; return true;
    }
    __device__ __forceinline__ void a_ready(const Unit&) const {}
    __device__ __forceinline__ void done(const Unit&) const {}
};
template <class Epi, class Sched, bool ALIGN_EPI = false, bool SP2 = false, bool FP8 = false, int PROBE = 0>
__device__ __forceinline__ void gemm_phase(PG8_LAS unsigned char* lds, const Gemm g, const Sched& S, const Epi& E) {
    const int tid = threadIdx.x, wid = __builtin_amdgcn_readfirstlane(tid >> 6), lane = tid & 63, wr = wid >> 2, wc = wid & 3, fr = lane & 15, fq = lane >> 4;
    const int K = g.K, nt = K / BK;
    unsigned voffA[2], voffB[2];
#pragma unroll
    for (int i = 0; i < 2; ++i) { int R, C; stage_rc(tid * 16 + i * 8192, R, C); const int Rb = Epi::PERM ? ((R & ~31) + perm32(R & 31)) : R;
        voffA[i] = (unsigned)(R * K + C) * 2u; voffB[i] = (unsigned)(Rb * K + C) * 2u; }
    const size_t kstep = (size_t)(BK * 2);
    const size_t hstep = (size_t)HALF * K * 2;
    const size_t tstep = 2 * hstep;
    const unsigned ldsw = (unsigned)wid * 1024u;
    const int aoff = lds_byte(wr * 64 + fr, fq * 8), boff = lds_byte(wc * 32 + fr, fq * 8);
#define PG8_SA(b, h) (((b) * 2 + (h)) * HTB)
#define PG8_SB(b, h) ((4 + (b) * 2 + (h)) * HTB)
#define PG8_STAGE(bufoff, gbase, voff) do { if (PROBE != 2) _Pragma("unroll") for (int _i = 0; _i < 2; ++_i) \
        __builtin_amdgcn_global_load_lds((const unsigned*)((const char*)(gbase) + (voff)[_i]), (PG8_LAS unsigned*)(lds + (bufoff) + ldsw + _i * 8192), 16, 0, 0); } while (0)
#define PG8_LDA(dst, b, h) do { _Pragma("unroll") for (int m = 0; m < 4; ++m) _Pragma("unroll") for (int k = 0; k < 2; ++k) dst[m][k] = *(const PG8_LAS bf16x8*)(lds + PG8_SA(b, h) + aoff + m * 2048 + k * 1024); } while (0)
#define PG8_LDB(dst, b, h) do { _Pragma("unroll") for (int n = 0; n < 2; ++n) _Pragma("unroll") for (int k = 0; k < 2; ++k) dst[n][k] = *(const PG8_LAS bf16x8*)(lds + PG8_SB(b, h) + boff + n * 2048 + k * 1024); } while (0)
#define PG8_CAT(x) __builtin_shufflevector(__builtin_bit_cast(i32x4, (x)[0]), __builtin_bit_cast(i32x4, (x)[1]), 0, 1, 2, 3, 4, 5, 6, 7)
#define PG8_MMA(ai, bj, At, Bt) do { __builtin_amdgcn_s_setprio(1); if constexpr (PROBE == 1) { asm volatile("" :: "v"(At[0][0]), "v"(At[3][1]), "v"(Bt[0][0]), "v"(Bt[1][1])); } else if constexpr (FP8) { _Pragma("unroll") for (int m = 0; m < 4; ++m) _Pragma("unroll") for (int n = 0; n < 2; ++n) \
        asm volatile("v_mfma_f32_16x16x128_f8f6f4 %0, %1, %2, %0" : "+v"(acc[ai][bj][m][n]) : "v"(PG8_CAT(Bt[n])), "v"(PG8_CAT(At[m]))); } else { \
        _Pragma("unroll") for (int m = 0; m < 4; ++m) _Pragma("unroll") for (int n = 0; n < 2; ++n) _Pragma("unroll") for (int k = 0; k < 2; ++k) \
        acc[ai][bj][m][n] = __builtin_amdgcn_mfma_f32_16x16x32_bf16(Bt[n][k], At[m][k], acc[ai][bj][m][n], 0, 0, 0); } __builtin_amdgcn_s_setprio(0); } while (0)
#define PG8_WAIT_V(n) asm volatile("s_waitcnt vmcnt(" #n ")" ::: "memory")
#define PG8_WAIT_L(n) asm volatile("s_waitcnt lgkmcnt(" #n ")" ::: "memory")
#define PG8_BAR __builtin_amdgcn_s_barrier()
#define PG8_SCHED __builtin_amdgcn_sched_barrier(0)
    Unit cur, nxt; int ui = 0;
    if (!S.next(0, cur)) return;
    f32x4 acc[2][2][4][2];
#pragma unroll
    for (int a = 0; a < 2; ++a)
#pragma unroll
        for (int b = 0; b < 2; ++b)
#pragma unroll
            for (int m = 0; m < 4; ++m)
#pragma unroll
                for (int n = 0; n < 2; ++n) acc[a][b][m][n] = (f32x4){0.f, 0.f, 0.f, 0.f};
    bf16x8 At[4][2], B0[2][2], B1[2][2];
    const char* cA = (const char*)g.A + (size_t)cur.pm * tstep; const char* cB = (const char*)g.Bt + (size_t)cur.pn * tstep;
    S.a_ready(cur);
    if constexpr (SP2) {
        PG8_STAGE(PG8_SB(0, 0), cB, voffB); PG8_STAGE(PG8_SB(0, 1), cB + hstep, voffB); PG8_STAGE(PG8_SA(0, 0), cA, voffA); PG8_STAGE(PG8_SA(0, 1), cA + hstep, voffA);
        if (wr == 1) PG8_BAR;
        PG8_WAIT_V(2); PG8_BAR;
        PG8_STAGE(PG8_SB(1, 0), cB + kstep, voffB); PG8_STAGE(PG8_SA(1, 0), cA + kstep, voffA); PG8_STAGE(PG8_SB(1, 1), cB + hstep + kstep, voffB);
        PG8_WAIT_V(6); PG8_BAR;
    } else {
        PG8_STAGE(PG8_SB(0, 0), cB, voffB); PG8_STAGE(PG8_SA(0, 0), cA, voffA); PG8_STAGE(PG8_SB(0, 1), cB + hstep, voffB); PG8_STAGE(PG8_SA(0, 1), cA + hstep, voffA);
        if (wr == 1) PG8_BAR;
        PG8_WAIT_V(4); PG8_BAR;
        PG8_STAGE(PG8_SB(1, 0), cB + kstep, voffB); PG8_STAGE(PG8_SA(1, 0), cA + kstep, voffA); PG8_STAGE(PG8_SB(1, 1), cB + hstep + kstep, voffB);
        PG8_WAIT_V(6); PG8_BAR;
    }
    for (;;) {
        const bool has_next = S.next(ui + 1, nxt);
        const char* nA = has_next ? (const char*)g.A + (size_t)nxt.pm * tstep : cA; const char* nB = has_next ? (const char*)g.Bt + (size_t)nxt.pn * tstep : cB;
        for (int t = 0; t < nt; t += 2) {
            const bool last = (t == nt - 2);
            const char* a1 = cA + (size_t)(t + 1) * kstep;
            const char* a2 = last ? nA : cA + (size_t)(t + 2) * kstep; const char* b2 = last ? nB : cB + (size_t)(t + 2) * kstep;
            const char* a3 = a2 + kstep; const char* b3 = b2 + kstep;
            if (last && has_next) S.a_ready(nxt);
            if constexpr (SP2) {
            PG8_LDB(B0, 0, 0); PG8_LDB(B1, 0, 1); PG8_SCHED; PG8_LDA(At, 0, 0); PG8_STAGE(PG8_SA(1, 1), a1 + hstep, voffA);
            PG8_WAIT_V(8); PG8_WAIT_L(0); PG8_BAR; PG8_MMA(0, 0, At, B0); PG8_MMA(0, 1, At, B1); PG8_BAR; PG8_SCHED;
            PG8_LDA(At, 0, 1); PG8_STAGE(PG8_SB(0, 0), b2, voffB); PG8_STAGE(PG8_SB(0, 1), b2 + hstep, voffB); PG8_STAGE(PG8_SA(0, 0), a2, voffA);
            PG8_WAIT_V(8); PG8_WAIT_L(0); PG8_BAR; PG8_MMA(1, 0, At, B0); PG8_MMA(1, 1, At, B1); PG8_BAR; PG8_SCHED;
            PG8_LDB(B0, 1, 0); PG8_LDB(B1, 1, 1); PG8_SCHED; PG8_LDA(At, 1, 0); PG8_STAGE(PG8_SA(0, 1), a2 + hstep, voffA);
            PG8_WAIT_V(8); PG8_WAIT_L(0); PG8_BAR; PG8_MMA(0, 0, At, B0); PG8_MMA(0, 1, At, B1); PG8_BAR; PG8_SCHED;
            PG8_LDA(At, 1, 1); PG8_STAGE(PG8_SB(1, 0), b3, voffB); PG8_STAGE(PG8_SB(1, 1), b3 + hstep, voffB); PG8_STAGE(PG8_SA(1, 0), a3, voffA);
            PG8_WAIT_V(8); PG8_WAIT_L(0); PG8_BAR; PG8_MMA(1, 0, At, B0); PG8_MMA(1, 1, At, B1); PG8_BAR; PG8_SCHED;
            } else {
            PG8_LDB(B0, 0, 0); PG8_SCHED; PG8_LDA(At, 0, 0); PG8_STAGE(PG8_SA(1, 1), a1 + hstep, voffA);
            PG8_WAIT_L(8); PG8_BAR; PG8_WAIT_L(0); PG8_MMA(0, 0, At, B0); PG8_BAR; PG8_SCHED;
            PG8_LDB(B1, 0, 1); PG8_STAGE(PG8_SB(0, 0), b2, voffB);
            PG8_BAR; PG8_WAIT_L(0); PG8_MMA(0, 1, At, B1); PG8_BAR;
            PG8_LDA(At, 0, 1); PG8_STAGE(PG8_SA(0, 0), a2, voffA);
            PG8_BAR; PG8_WAIT_L(0); PG8_MMA(1, 0, At, B0); PG8_BAR; PG8_SCHED;
            PG8_STAGE(PG8_SB(0, 1), b2 + hstep, voffB);
            PG8_WAIT_V(6); PG8_BAR; PG8_MMA(1, 1, At, B1); PG8_BAR;
            PG8_LDB(B0, 1, 0); PG8_SCHED; PG8_LDA(At, 1, 0); PG8_STAGE(PG8_SA(0, 1), a2 + hstep, voffA);
            PG8_WAIT_L(8); PG8_BAR; PG8_WAIT_L(0); PG8_MMA(0, 0, At, B0); PG8_BAR; PG8_SCHED;
            PG8_LDB(B1, 1, 1); PG8_STAGE(PG8_SB(1, 0), b3, voffB);
            PG8_BAR; PG8_WAIT_L(0); PG8_MMA(0, 1, At, B1); PG8_BAR;
            PG8_LDA(At, 1, 1); PG8_STAGE(PG8_SA(1, 0), a3, voffA);
            PG8_BAR; PG8_WAIT_L(0); PG8_MMA(1, 0, At, B0); PG8_BAR; PG8_SCHED;
            PG8_STAGE(PG8_SB(1, 1), b3 + hstep, voffB);
            PG8_WAIT_V(6); PG8_BAR; PG8_MMA(1, 1, At, B1); PG8_BAR;
            }
        }
        if constexpr (ALIGN_EPI) { if (wr == 0) PG8_BAR; }
        if constexpr (FP8) asm volatile("s_nop 15\n\ts_nop 15" ::: "memory");
        if constexpr (!Epi::AFTER_DRAIN) { E(acc, cur, wr, wc, fr, fq); S.done(cur); }
        if (!has_next) break;
#pragma unroll
        for (int a = 0; a < 2; ++a)
#pragma unroll
            for (int b = 0; b < 2; ++b)
#pragma unroll
                for (int m = 0; m < 4; ++m)
#pragma unroll
                    for (int n = 0; n < 2; ++n) acc[a][b][m][n] = (f32x4){0.f, 0.f, 0.f, 0.f};
        cur = nxt; cA = nA; cB = nB; ++ui;
        if constexpr (ALIGN_EPI) { if (wr == 1) PG8_BAR; }
    }
    PG8_WAIT_V(0);
    if constexpr (!ALIGN_EPI) { if (wr == 0) PG8_BAR; }
    PG8_BAR;
    if constexpr (Epi::AFTER_DRAIN) { E.fused(acc, cur, wr, wc, fr, fq, lds, wid, lane); S.done(cur); }
#undef PG8_SA
#undef PG8_SB
#undef PG8_STAGE
#undef PG8_LDA
#undef PG8_LDB
#undef PG8_MMA
#undef PG8_CAT
#undef PG8_WAIT_V
#undef PG8_WAIT_L
#undef PG8_BAR
#undef PG8_SCHED
}
}
namespace pg8 {
template <class Epi, class Sched, bool GATHER, int PROBE = 0>
__device__ __forceinline__ void gemm_phase_ut(PG8_LAS unsigned char* lds, const Gemm g, const Sched& S, const Epi& E) {
    const int tid = threadIdx.x, wid = __builtin_amdgcn_readfirstlane(tid >> 6), lane = tid & 63, wr = wid >> 2, wc = wid & 3, fr = lane & 15, fq = lane >> 4;
    const int K = g.K, nt = K / BK;
    unsigned voffA[2], voffB[2]; int R0, C0; stage_rc(tid * 16, R0, C0);
#pragma unroll
    for (int i = 0; i < 2; ++i) { int R, C; stage_rc(tid * 16 + i * 8192, R, C); const int Rb = Epi::PERM ? ((R & ~31) + perm32(R & 31)) : R;
        voffA[i] = (unsigned)(R * K + C) * 2u; voffB[i] = (unsigned)(Rb * K + C) * 2u; }
    const size_t kstep = (size_t)(BK * 2), hstep = (size_t)HALF * K * 2, tstep = 2 * hstep;
    const unsigned ldsw = (unsigned)wid * 1024u;
    const int aoff = lds_byte(wr * 64 + fr, fq * 8), boff = lds_byte(wc * 32 + fr, fq * 8);
    PG8_LAS unsigned char* utab = S.utab;
#define PG8_SA(b, h) (((b) * 2 + (h)) * HTB)
#define PG8_SB(b, h) ((4 + (b) * 2 + (h)) * HTB)
#define PG8_STAGE(bufoff, gbase, voff) do { if (PROBE != 2) _Pragma("unroll") for (int _i = 0; _i < 2; ++_i) \
        __builtin_amdgcn_global_load_lds((const unsigned*)((const char*)(gbase) + (voff)[_i]), (PG8_LAS unsigned*)(lds + (bufoff) + ldsw + _i * 8192), 16, 0, 0); } while (0)
#define PG8_STAGE_A(b, h, dense_ptr, kt_ptr, off) do { if constexpr (GATHER) { PG8_STAGE(PG8_SA(b, h), kt_ptr, (off)[h]); } else { PG8_STAGE(PG8_SA(b, h), (dense_ptr) + (h) * hstep, voffA); } } while (0)
#define PG8_LDA(dst, b, h) do { _Pragma("unroll") for (int m = 0; m < 4; ++m) _Pragma("unroll") for (int k = 0; k < 2; ++k) dst[m][k] = *(const PG8_LAS bf16x8*)(lds + PG8_SA(b, h) + aoff + m * 2048 + k * 1024); } while (0)
#define PG8_LDB(dst, b, h) do { _Pragma("unroll") for (int n = 0; n < 2; ++n) _Pragma("unroll") for (int k = 0; k < 2; ++k) dst[n][k] = *(const PG8_LAS bf16x8*)(lds + PG8_SB(b, h) + boff + n * 2048 + k * 1024); } while (0)
#define PG8_CAT(x) __builtin_shufflevector(__builtin_bit_cast(i32x4, (x)[0]), __builtin_bit_cast(i32x4, (x)[1]), 0, 1, 2, 3, 4, 5, 6, 7)
#define PG8_MMA(ai, bj, At, Bt) do { __builtin_amdgcn_s_setprio(1); if constexpr (PROBE == 1) { asm volatile("" :: "v"(At[0][0]), "v"(At[3][1]), "v"(Bt[0][0]), "v"(Bt[1][1])); } else _Pragma("unroll") for (int m = 0; m < 4; ++m) _Pragma("unroll") for (int n = 0; n < 2; ++n) \
        asm volatile("v_mfma_f32_16x16x128_f8f6f4 %0, %1, %2, %0" : "+v"(acc[ai][bj][m][n]) : "v"(PG8_CAT(Bt[n])), "v"(PG8_CAT(At[m]))); __builtin_amdgcn_s_setprio(0); } while (0)
#define PG8_WAIT_V(n) asm volatile("s_waitcnt vmcnt(" #n ")" ::: "memory")
#define PG8_WAIT_L(n) asm volatile("s_waitcnt lgkmcnt(" #n ")" ::: "memory")
#define PG8_BAR __builtin_amdgcn_s_barrier()
#define PG8_SCHED __builtin_amdgcn_sched_barrier(0)
#define PG8_UT_FILL(u, slot) do { if (wid == 0) { const char *sa_, *sb_; S.srcs(u, lane, sa_, sb_); \
        __builtin_amdgcn_global_load_lds((const unsigned*)sa_, (PG8_LAS unsigned*)(utab + (slot) * 2048), 16, 0, 0); \
        __builtin_amdgcn_global_load_lds((const unsigned*)sb_, (PG8_LAS unsigned*)(utab + (slot) * 2048 + 1024), 16, 0, 0); } } while (0)
#define PG8_UT_OFFS(dst, slot) do { _Pragma("unroll") for (int _h = 0; _h < 2; ++_h) _Pragma("unroll") for (int _i = 0; _i < 2; ++_i) \
        dst[_h][_i] = *(const PG8_LAS unsigned*)(utab + (slot) * 2048 + (_h * HALF + R0 + 64 * _i) * 4) + (unsigned)C0 * 2u; } while (0)
    Unit cur, nxt; int ui = 0, cslot = 0;
    if (!S.next(0, cur)) return;
    f32x4 acc[2][2][4][2];
#pragma unroll
    for (int a = 0; a < 2; ++a)
#pragma unroll
        for (int b = 0; b < 2; ++b)
#pragma unroll
            for (int m = 0; m < 4; ++m)
#pragma unroll
                for (int n = 0; n < 2; ++n) acc[a][b][m][n] = (f32x4){0.f, 0.f, 0.f, 0.f};
    bf16x8 At[4][2], B0[2][2], B1[2][2];
    unsigned cOff[2][2], sOff[2][2];
    const char* cA = (const char*)g.A + (GATHER ? (size_t)0 : (size_t)cur.pm * tstep); const char* cB = (const char*)g.Bt + (size_t)cur.pn * tstep;
    PG8_UT_FILL(cur, 0); PG8_WAIT_V(0); PG8_BAR; asm volatile("" ::: "memory");
    if constexpr (GATHER) { PG8_UT_OFFS(cOff, 0); }
#pragma unroll
    for (int h = 0; h < 2; ++h)
#pragma unroll
        for (int i = 0; i < 2; ++i) { if (!GATHER) cOff[h][i] = 0u; sOff[h][i] = cOff[h][i]; }
    PG8_STAGE(PG8_SB(0, 0), cB, voffB); PG8_STAGE(PG8_SB(0, 1), cB + hstep, voffB); PG8_STAGE_A(0, 0, cA, cA, cOff); PG8_STAGE_A(0, 1, cA, cA, cOff);
    if (wr == 1) PG8_BAR;
    PG8_WAIT_V(2); PG8_BAR;
    PG8_STAGE(PG8_SB(1, 0), cB + kstep, voffB); PG8_STAGE_A(1, 0, cA + kstep, cA + kstep, cOff); PG8_STAGE(PG8_SB(1, 1), cB + hstep + kstep, voffB);
    PG8_WAIT_V(6); PG8_BAR;
    for (;;) {
        const bool has_next = S.next(ui + 1, nxt); const int nslot = cslot == 2 ? 0 : cslot + 1;
        if (has_next) PG8_UT_FILL(nxt, nslot);
        const char* nA = GATHER ? cA : (has_next ? (const char*)g.A + (size_t)nxt.pm * tstep : cA); const char* nB = has_next ? (const char*)g.Bt + (size_t)nxt.pn * tstep : cB;
        for (int t = 0; t < nt; t += 2) {
            const bool last = (t == nt - 2);
            const char* a1 = cA + (size_t)(t + 1) * kstep;
            const char* a2 = last ? nA : cA + (size_t)(t + 2) * kstep; const char* b2 = last ? nB : cB + (size_t)(t + 2) * kstep;
            const char* a3 = a2 + kstep; const char* b3 = b2 + kstep;
            if constexpr (GATHER) { if (last && has_next) { PG8_UT_OFFS(sOff, nslot); } }
            PG8_LDB(B0, 0, 0); PG8_LDB(B1, 0, 1); PG8_SCHED; PG8_LDA(At, 0, 0); PG8_STAGE_A(1, 1, a1, a1, cOff);
            PG8_WAIT_V(8); PG8_WAIT_L(0); PG8_BAR; PG8_MMA(0, 0, At, B0); PG8_MMA(0, 1, At, B1); PG8_BAR; PG8_SCHED;
            PG8_LDA(At, 0, 1); PG8_STAGE(PG8_SB(0, 0), b2, voffB); PG8_STAGE(PG8_SB(0, 1), b2 + hstep, voffB); PG8_STAGE_A(0, 0, a2, a2, sOff);
            PG8_WAIT_V(8); PG8_WAIT_L(0); PG8_BAR; PG8_MMA(1, 0, At, B0); PG8_MMA(1, 1, At, B1); PG8_BAR; PG8_SCHED;
            PG8_LDB(B0, 1, 0); PG8_LDB(B1, 1, 1); PG8_SCHED; PG8_LDA(At, 1, 0); PG8_STAGE_A(0, 1, a2, a2, sOff);
            PG8_WAIT_V(8); PG8_WAIT_L(0); PG8_BAR; PG8_MMA(0, 0, At, B0); PG8_MMA(0, 1, At, B1); PG8_BAR; PG8_SCHED;
            PG8_LDA(At, 1, 1); PG8_STAGE(PG8_SB(1, 0), b3, voffB); PG8_STAGE(PG8_SB(1, 1), b3 + hstep, voffB); PG8_STAGE_A(1, 0, a3, a3, sOff);
            PG8_WAIT_V(8); PG8_WAIT_L(0); PG8_BAR; PG8_MMA(1, 0, At, B0); PG8_MMA(1, 1, At, B1); PG8_BAR; PG8_SCHED;
        }
        if (wr == 0) PG8_BAR;
        asm volatile("s_nop 15\n\ts_nop 15" ::: "memory");
        E(acc, cur, wr, wc, fr, fq, (const PG8_LAS unsigned char*)(utab + cslot * 2048));
        if (!has_next) break;
#pragma unroll
        for (int a = 0; a < 2; ++a)
#pragma unroll
            for (int b = 0; b < 2; ++b)
#pragma unroll
                for (int m = 0; m < 4; ++m)
#pragma unroll
                    for (int n = 0; n < 2; ++n) acc[a][b][m][n] = (f32x4){0.f, 0.f, 0.f, 0.f};
        cur = nxt; cA = nA; cB = nB; ++ui; cslot = nslot;
#pragma unroll
        for (int h = 0; h < 2; ++h)
#pragma unroll
            for (int i = 0; i < 2; ++i) cOff[h][i] = sOff[h][i];
        if (wr == 1) PG8_BAR;
    }
    PG8_WAIT_V(0);
    PG8_BAR;
#undef PG8_SA
#undef PG8_SB
#undef PG8_STAGE
#undef PG8_STAGE_A
#undef PG8_LDA
#undef PG8_LDB
#undef PG8_CAT
#undef PG8_MMA
#undef PG8_WAIT_V
#undef PG8_WAIT_L
#undef PG8_BAR
#undef PG8_SCHED
#undef PG8_UT_FILL
#undef PG8_UT_OFFS
}
}
constexpr int NWAVES = 8;
constexpr int MKV_SHIFT = 2176 % 256;
constexpr int NTOK = 32768, DM = 2048, DPJ = 4352, SEQ = 4096, NMEM = 256, NEXP = 32;
constexpr int ZU = 0, ZV = 768, ZQ = 1536, ZK = 2304, ZW = 3072, ZM = 3840;
constexpr float LN_EPS = 1e-5f, DN_ALPHA = 1.189207115002721f, ATT_SCALE = 0.08838834764831845f;
constexpr int MAXTILES = 544, MAXROWS = MAXTILES * 256;
constexpr float W_SCALE = 64.0f, XS_SCALE = 8.0f, ACT_SCALE = 4.0f, YS_SCALE = 16.0f;
constexpr size_t MiB = 1u << 20;
constexpr size_t WS_CTL = 0, CTL_ZERO_BYTES = 1 * MiB;
constexpr size_t WS_WINT = 1 * MiB;
constexpr size_t WS_WMKVT = WS_WINT + 17 * MiB;
constexpr size_t WS_WOUTT = WS_WMKVT + 4 * MiB;
constexpr size_t WS_WGUT = WS_WOUTT + 8 * MiB;
constexpr size_t WS_WDT = WS_WGUT + 512 * MiB;
constexpr size_t WS_XB = WS_WDT + 256 * MiB;
constexpr size_t WS_MEMB = WS_XB + 128 * MiB;
constexpr size_t WS_Z = WS_MEMB + 8 * MiB;
constexpr size_t WS_MKV = WS_Z + 272 * MiB;
constexpr size_t WS_Y = WS_MKV + 4 * MiB;
constexpr size_t WS_H1 = WS_Y + 128 * MiB;
constexpr size_t WS_X1Q = WS_H1 + 256 * MiB;
constexpr size_t WS_XS = WS_X1Q + 128 * MiB;
constexpr size_t WS_ACT = WS_XS + 544 * MiB;
constexpr size_t WS_YS = WS_ACT + 544 * MiB;
constexpr size_t WS_LIST = WS_YS + 544 * MiB;
constexpr size_t WS_GATEL = WS_LIST + 4 * MiB;
constexpr size_t WS_ROWGATE = WS_GATEL + 4 * MiB;
constexpr size_t WS_SLOTROW = WS_ROWGATE + 1 * MiB;
constexpr size_t WS_WRF = WS_SLOTROW + 1 * MiB;
constexpr size_t WS_STATS = WS_WRF + 1 * MiB;
constexpr size_t WS_ROWOFF = WS_STATS + 1 * MiB;
constexpr size_t WS_END = WS_ROWOFF + 1 * MiB;
constexpr size_t WS_OATT = WS_XS;
constexpr size_t WS_LSE = WS_XS + 144 * MiB;
constexpr int CW_BAR = 4096;
constexpr int CW_CNT = 16384;
constexpr int RING_BYTES = 131072;
constexpr int LDSCTL_OFF = 143360;
constexpr int UTAB_OFF = 131072;
constexpr int LDS_BYTES = 147456;

#define GAS __attribute__((address_space(1)))
#define LAS __attribute__((address_space(3)))
typedef unsigned short bf16;
typedef unsigned v4u __attribute__((ext_vector_type(4)));
typedef unsigned v2u __attribute__((ext_vector_type(2)));
typedef float f32x4 __attribute__((ext_vector_type(4)));
#define LDS_WAIT() asm volatile("s_waitcnt lgkmcnt(0)" ::: "memory")
__device__ __forceinline__ unsigned pk2(float lo, float hi) { unsigned r; asm volatile("v_cvt_pk_bf16_f32 %0, %1, %2" : "=v"(r) : "v"(lo), "v"(hi)); return r; }
__device__ __forceinline__ float bflo(unsigned w) { return __uint_as_float(w << 16); }
__device__ __forceinline__ float bfhi(unsigned w) { return __uint_as_float(w & 0xffff0000u); }
__device__ __forceinline__ float wave_sum(float v) {
#pragma unroll
    for (int o = 1; o < 64; o <<= 1) v += __shfl_xor(v, o);
    return v;
}
__device__ __forceinline__ float wave_max(float v) {
#pragma unroll
    for (int o = 1; o < 64; o <<= 1) v = fmaxf(v, __shfl_xor(v, o));
    return v;
}
#define XB_TMO      128
#define XB_XCNT(j)  (256  + 64 * (j))
#define XB_XSUB(j)  (1280 + 64 * (j))
#define XB_XGEN(j)  (2304 + 64 * (j))
#define XB_TOP      3328
#define XB_TOPGEN   3392
#define XCD_BAR_WORDS 3456
#define XB_SPIN_CAP (1u << 18)

__device__ __forceinline__ unsigned xb_ld(unsigned* p)              { return __hip_atomic_load(p, __ATOMIC_RELAXED, __HIP_MEMORY_SCOPE_AGENT); }
__device__ __forceinline__ unsigned xb_add(unsigned* p, unsigned v) { return __hip_atomic_fetch_add(p, v, __ATOMIC_RELAXED, __HIP_MEMORY_SCOPE_AGENT); }
__device__ __forceinline__ unsigned xb_xcc_id() { return (unsigned)__builtin_amdgcn_s_getreg((3 << 11) | 20) & 0xFu; }
#define XB_SPIN(cond, bar) do { unsigned _sp = 0; while (cond) { __builtin_amdgcn_s_sleep(1); \
    if ((++_sp & 255u) == 0u) { if (xb_ld(&(bar)[XB_TMO])) break; if (_sp > XB_SPIN_CAP) { atomicAdd(&(bar)[XB_TMO], 1u); break; } } } } while (0)

struct XcdBarrier {
    unsigned* bar; unsigned x;
    volatile LAS unsigned* st;
};

__device__ __forceinline__ XcdBarrier xcd_barrier_post(unsigned* bar, volatile LAS unsigned* st) {
    XcdBarrier b; b.bar = bar; b.x = xb_xcc_id(); b.st = st;
    if (threadIdx.x == 0) (void)xb_add(&bar[XB_XCNT(b.x)], 1u);
    return b;
}
__device__ __forceinline__ void xcd_barrier_complete(unsigned* bar, unsigned x, unsigned& nloc, unsigned& nx) {
    const unsigned G = gridDim.x * gridDim.y * gridDim.z;
    unsigned sum, cnt, mine, sp = 0u;
    for (;;) {
        sum = 0u; cnt = 0u; mine = 0u;
#pragma unroll
        for (unsigned j = 0; j < 16; ++j) { const unsigned c = xb_ld(&bar[XB_XCNT(j)]); sum += c; cnt += (c > 0u) ? 1u : 0u; mine = (j == x) ? c : mine; }
        if (sum == G) break;
        __builtin_amdgcn_s_sleep(1);
        if ((++sp & 255u) == 0u) { if (xb_ld(&bar[XB_TMO])) break; if (sp > XB_SPIN_CAP) { atomicAdd(&bar[XB_TMO], 1u); break; } }
    }
    nloc = mine > 0u ? mine : 1u; nx = cnt > 0u ? cnt : 1u;
}

__device__ __forceinline__ void xcd_barrier(const XcdBarrier& b) {
    asm volatile("s_waitcnt vmcnt(0)" ::: "memory");
    __syncthreads();
    if (threadIdx.x == 0) {
        unsigned* bar = b.bar;
        __builtin_amdgcn_s_waitcnt(0);
        unsigned nloc = b.st[0], nx = b.st[1];
        if (nloc == 0u) { xcd_barrier_complete(bar, b.x, nloc, nx); b.st[0] = nloc; b.st[1] = nx; }
        const unsigned old = xb_add(&bar[XB_XSUB(b.x)], 1u);
        const unsigned gen = old / nloc;
        if (old + 1u == (gen + 1u) * nloc) {
            __builtin_amdgcn_fence(__ATOMIC_RELEASE, "agent");
            asm volatile("s_waitcnt vmcnt(0)" ::: "memory");
            const unsigned og = xb_add(&bar[XB_TOP], 1u);
            const unsigned tg = og / nx;
            if (og + 1u == (tg + 1u) * nx) xb_add(&bar[XB_TOPGEN], 1u);
            else XB_SPIN(xb_ld(&bar[XB_TOPGEN]) == tg, bar);
            __builtin_amdgcn_fence(__ATOMIC_ACQUIRE, "agent");
            xb_add(&bar[XB_XGEN(b.x)], 1u);
            asm volatile("s_waitcnt vmcnt(0)" ::: "memory");
        } else {
            XB_SPIN(xb_ld(&bar[XB_XGEN(b.x)]) == gen, bar);
            __builtin_amdgcn_fence(__ATOMIC_ACQUIRE, "agent");
            asm volatile("s_waitcnt vmcnt(0)" ::: "memory");
        }
    }
    __syncthreads();
}
struct Args { const float* in[22]; float* out; unsigned char* ws; int ph_lo, ph_hi; };
enum { I_X = 0, I_MEM, I_WIN, I_WSP, I_BSP, I_ALNG, I_ALNB, I_WMKV, I_NAG, I_NBG, I_NMG, I_WOUT, I_LN1G, I_LN1B, I_WR, I_BR, I_WGU, I_BGU, I_WD, I_BD, I_LN2G, I_LN2B };

__device__ __forceinline__ void tr_item(const float* __restrict__ W, int N, bf16* WT, int k0, int n0, int drow0, const float* ga, const float* gb, const float* gm, LAS float* scr, int lane) {
    float tv[32];
#pragma unroll
    for (int i = 0; i < 32; ++i) tv[i] = W[(size_t)(k0 + 2 * i + (lane >> 5)) * N + n0 + (lane & 31)];
    if (ga) { const float* gp = (k0 < 768) ? ga + k0 : (k0 < 1536 ? gb + (k0 - 768) : gm + (k0 - 1536)); float gv[32];
#pragma unroll
        for (int i = 0; i < 32; ++i) gv[i] = gp[2 * i + (lane >> 5)];
#pragma unroll
        for (int i = 0; i < 32; ++i) tv[i] *= gv[i]; }
#pragma unroll
    for (int i = 0; i < 32; ++i) scr[(2 * i + (lane >> 5)) * 33 + (lane & 31)] = tv[i];
    LDS_WAIT(); asm volatile("" ::: "memory");
    const int c = lane & 7;
#pragma unroll
    for (int j = 0; j < 4; ++j) { const int n = (lane >> 3) + 8 * j; const LAS float* s = scr + (8 * c) * 33 + n;
        v4u o; o.x = pk2(s[0 * 33], s[1 * 33]); o.y = pk2(s[2 * 33], s[3 * 33]); o.z = pk2(s[4 * 33], s[5 * 33]); o.w = pk2(s[6 * 33], s[7 * 33]);
        *(v4u*)(WT + (size_t)(drow0 + n) * 2048 + k0 + 8 * c) = o; }
    LDS_WAIT(); asm volatile("" ::: "memory");
}
__device__ __forceinline__ unsigned pk4_fp8(float a, float b, float c, float d) { int r = __builtin_amdgcn_cvt_pk_fp8_f32(a, b, 0, false); r = __builtin_amdgcn_cvt_pk_fp8_f32(c, d, r, true); return (unsigned)r; }
__device__ __forceinline__ void tr_item_fp8(const float* __restrict__ W, int N, unsigned char* WT, int k0, int n0, int drow0, float scale, LAS float* scr, int lane) {
    float tv[32];
#pragma unroll
    for (int i = 0; i < 32; ++i) tv[i] = W[(size_t)(k0 + 2 * i + (lane >> 5)) * N + n0 + (lane & 31)];
#pragma unroll
    for (int i = 0; i < 32; ++i) scr[(2 * i + (lane >> 5)) * 33 + (lane & 31)] = tv[i] * scale;
    LDS_WAIT(); asm volatile("" ::: "memory");
    const int c = lane & 7;
#pragma unroll
    for (int j = 0; j < 4; ++j) { const int n = (lane >> 3) + 8 * j; const LAS float* s = scr + (8 * c) * 33 + n;
        v2u o; o.x = pk4_fp8(s[0 * 33], s[1 * 33], s[2 * 33], s[3 * 33]); o.y = pk4_fp8(s[4 * 33], s[5 * 33], s[6 * 33], s[7 * 33]);
        *(v2u*)(WT + (size_t)(drow0 + n) * 2048 + k0 + 8 * c) = o; }
    LDS_WAIT(); asm volatile("" ::: "memory");
}
struct MoeItem { const float* W; unsigned char* WT; int N, k0, n0, drow0; };
__device__ __forceinline__ MoeItem moe_item(const Args& a, int it) {
    constexpr int I_GU1 = 32 * 128, I_DN1 = 32 * 64; MoeItem m; unsigned char* ws = a.ws; int r = it;
    if (r < 32 * I_GU1) { const int e = r / I_GU1, rr = r % I_GU1, kb = rr / 128, nb = rr % 128, n0 = 32 * nb; const int s = n0 >> 11, jj = n0 & 2047;
        m.W = a.in[I_WGU] + (size_t)e * 2048 * 4096; m.N = 4096; m.WT = ws + WS_WGUT; m.k0 = 64 * kb; m.n0 = n0; m.drow0 = e * 4096 + 256 * (jj >> 7) + 128 * s + (jj & 127); return m; }
    r -= 32 * I_GU1; { const int e = r / I_DN1, rr = r % I_DN1, kb = rr / 64, nb = rr % 64;
        m.W = a.in[I_WD] + (size_t)e * 2048 * 2048; m.N = 2048; m.WT = ws + WS_WDT; m.k0 = 64 * kb; m.n0 = 32 * nb; m.drow0 = e * 2048 + 32 * nb; return m; }
}
__device__ __forceinline__ void moe_conv_lds(const Args& a, LAS unsigned char* lds, int lane, int wave, int gw, int NGW) {
    LAS float* scr = (LAS float*)(lds + wave * 16384);
    constexpr int NIT = 32 * (32 * 128 + 32 * 64);
#define MC_LOAD(M_, TV) do { _Pragma("unroll") for (int i = 0; i < 32; ++i) TV[i] = M_.W[(size_t)(M_.k0 + 2 * i + (lane >> 5)) * M_.N + M_.n0 + (lane & 31)]; } while (0)
#define MC_STORE(M_, TV) do { _Pragma("unroll") for (int i = 0; i < 32; ++i) scr[(2 * i + (lane >> 5)) * 33 + (lane & 31)] = TV[i] * W_SCALE; \
        LDS_WAIT(); asm volatile("" ::: "memory"); const int c = lane & 7; \
        _Pragma("unroll") for (int j = 0; j < 4; ++j) { const int n = (lane >> 3) + 8 * j; const LAS float* s = scr + (8 * c) * 33 + n; \
            v2u o; o.x = pk4_fp8(s[0 * 33], s[1 * 33], s[2 * 33], s[3 * 33]); o.y = pk4_fp8(s[4 * 33], s[5 * 33], s[6 * 33], s[7 * 33]); \
            *(v2u*)(M_.WT + (size_t)(M_.drow0 + n) * 2048 + M_.k0 + 8 * c) = o; } \
        LDS_WAIT(); asm volatile("" ::: "memory"); } while (0)
#define MC_NEXT(I_) (((I_) + NGW < NIT) ? (I_) + NGW : (I_))
    int cur = gw; if (cur >= NIT) return;
    float tA[32], tB[32]; int n1 = MC_NEXT(cur);
    MoeItem mA = moe_item(a, cur), mB = moe_item(a, n1);
    MC_LOAD(mA, tA);
    for (;;) {
        MC_LOAD(mB, tB); asm volatile("" ::: "memory");
        MC_STORE(mA, tA);
        if (n1 == cur) break;
        cur = n1; n1 = MC_NEXT(n1); mA = moe_item(a, n1);
        MC_LOAD(mA, tA); asm volatile("" ::: "memory");
        MC_STORE(mB, tB);
        if (n1 == cur) break;
        cur = n1; n1 = MC_NEXT(n1); mB = moe_item(a, n1);
    }
#undef MC_LOAD
#undef MC_STORE
#undef MC_NEXT
}
__device__ __forceinline__ void p0_prep(const Args& a, LAS unsigned char* lds, int tid, int lane, int wave, int vcu, int G) {
    unsigned char* ws = a.ws;
    {
        const size_t n8x = (size_t)NTOK * DM / 8, n8m = (size_t)2048 * 2048 / 8;
        const size_t NT8 = n8x + n8m, st8 = (size_t)G * 512;
        for (size_t i0 = (size_t)vcu * 512 + tid; i0 < NT8; i0 += 4 * st8) { f32x4 p[4], q[4];
#pragma unroll
            for (int u = 0; u < 4; ++u) { const size_t i = i0 + u * st8; if (i < NT8) { const float* src = i < n8x ? a.in[I_X] + 8 * i : a.in[I_MEM] + 8 * (i - n8x); p[u] = *(const f32x4*)src; q[u] = *(const f32x4*)(src + 4); } }
#pragma unroll
            for (int u = 0; u < 4; ++u) { const size_t i = i0 + u * st8; if (i < NT8) { bf16* dst = i < n8x ? (bf16*)(ws + WS_XB) + 8 * i : (bf16*)(ws + WS_MEMB) + 8 * (i - n8x);
                v4u o; o.x = pk2(p[u][0], p[u][1]); o.y = pk2(p[u][2], p[u][3]); o.z = pk2(q[u][0], q[u][1]); o.w = pk2(q[u][2], q[u][3]);
                *(v4u*)dst = o; } } }
    }
    {
        bf16* WRB = (bf16*)(ws + WS_WRF); float* C12 = (float*)(ws + WS_WRF + 512 * 1024); bf16* GB16 = (bf16*)(ws + WS_WRF + 768 * 1024); const float* wr = a.in[I_WR]; const float* lg = a.in[I_LN1G]; const float* lb = a.in[I_LN1B];
        for (int idx = vcu * 512 + tid; idx < 65536; idx += G * 512) { const int jj = idx & 7, ln = (idx >> 3) & 63, nt = (idx >> 9) & 1, s = idx >> 10;
            const int k = 32 * s + 8 * (ln >> 4) + jj, e = 16 * nt + (ln & 15); const float w = lg[k] * wr[k * 32 + e]; const unsigned hi = pk2(w, 0.f) & 0xffffu; const float rem = w - __uint_as_float(hi << 16);
            WRB[(size_t)((s * 2 + nt) * 2 + 0) * 512 + ln * 8 + jj] = (bf16)hi; WRB[(size_t)((s * 2 + nt) * 2 + 1) * 512 + ln * 8 + jj] = (bf16)(pk2(rem, 0.f) & 0xffffu); }
        for (int k = vcu * 512 + tid; k < 2048; k += G * 512) { GB16[k] = (bf16)(pk2(lg[k], 0.f) & 0xffffu); GB16[2048 + k] = (bf16)(pk2(lb[k] * XS_SCALE, 0.f) & 0xffffu); }
        if (vcu == 0) { LAS float* red = (LAS float*)lds; const int e = tid & 31, kr = tid >> 5; float s1 = 0.f, s2 = 0.f;
#pragma unroll 1
            for (int kb = kr * 128; kb < kr * 128 + 128; kb += 16) { float wv[16], gv[16], bv[16];
#pragma unroll
                for (int j = 0; j < 16; ++j) { wv[j] = wr[(kb + j) * 32 + e]; gv[j] = lg[kb + j]; bv[j] = lb[kb + j]; }
#pragma unroll
                for (int j = 0; j < 16; ++j) { s1 += gv[j] * wv[j]; s2 += bv[j] * wv[j]; } }
            red[kr * 32 + e] = s1; red[512 + kr * 32 + e] = s2; __syncthreads();
            if (tid < 32) { float t1 = 0.f, t2 = 0.f; for (int j = 0; j < 16; ++j) { t1 += red[j * 32 + tid]; t2 += red[512 + j * 32 + tid]; } C12[tid] = t1; C12[32 + tid] = t2 + a.in[I_BR][tid]; }
            __syncthreads(); } }
    LAS float* scr = (LAS float*)(lds + wave * 16384);
    const int gw = vcu * NWAVES + wave, NGW = G * NWAVES;
    constexpr int I_IN = 32 * 136, I_MKV = 32 * 32, I_OUT = 32 * 64, I_GU1 = 32 * 128, I_DN1 = 32 * 64;
    constexpr int NITEMS = I_IN + I_MKV + I_OUT;
    for (int it = gw; it < NITEMS; it += NGW) {
        int r = it;
        if (r < I_IN) { tr_item(a.in[I_WIN], DPJ, (bf16*)(ws + WS_WINT), 64 * (r / 136), 32 * (r % 136), 32 * (r % 136), nullptr, nullptr, nullptr, scr, lane); continue; } r -= I_IN;
        if (r < I_MKV) { tr_item(a.in[I_WMKV], 1024, (bf16*)(ws + WS_WMKVT), 64 * (r / 32), 32 * (r % 32), 32 * (r % 32), nullptr, nullptr, nullptr, scr, lane); continue; } r -= I_MKV;
        { tr_item(a.in[I_WOUT], 2048, (bf16*)(ws + WS_WOUTT), 64 * (r / 64), 32 * (r % 64), 32 * (r % 64), a.in[I_NAG], a.in[I_NBG], a.in[I_NMG], scr, lane); }
    }
}

__device__ __forceinline__ void moe_table(const Args& a, LAS int* tb, LAS int* cn, int tid) {
    const unsigned* ctl = (const unsigned*)(a.ws + WS_CTL);
    if (tid < 64) {
        const int e = tid & 31; const int c = (tid < 32) ? (int)__hip_atomic_load(ctl + CW_CNT + 64 * e, __ATOMIC_RELAXED, __HIP_MEMORY_SCOPE_AGENT) : 0;
        const int tiles = (c + 255) >> 8; int x = tiles;
#pragma unroll
        for (int o = 1; o < 32; o <<= 1) { const int y = __shfl_up(x, o); if (tid >= o) x += y; }
        if (tid < 32) { tb[e] = x - tiles; cn[e] = c; if (e == 31) tb[32] = x; } }
    __syncthreads();
}
__device__ __forceinline__ void p6_tables(const Args& a, LAS int* tb, LAS int* cn, int tid, int vcu, int G) {
    const int* LIST = (const int*)(a.ws + WS_LIST); const float* GATEL = (const float*)(a.ws + WS_GATEL);
    unsigned* ROWOFF = (unsigned*)(a.ws + WS_ROWOFF); float* ROWGATE = (float*)(a.ws + WS_ROWGATE); int* SLOTROW = (int*)(a.ws + WS_SLOTROW);
    const int nrows = tb[32] * 256;
    for (int grow = vcu * 512 + tid; grow < nrows; grow += G * 512) { const int tile = grow >> 8; int e = 0;
#pragma unroll
        for (int j = 1; j < 32; ++j) e += (tb[j] <= tile) ? 1 : 0;
        const int rank = grow - tb[e] * 256;
        if (rank < cn[e]) { const int entry = LIST[(size_t)e * NTOK + rank]; ROWOFF[grow] = (unsigned)(entry >> 2) * (unsigned)DM; ROWGATE[grow] = GATEL[(size_t)e * NTOK + rank]; SLOTROW[entry] = grow; }
        else { ROWOFF[grow] = 0u; ROWGATE[grow] = 0.f; } }
}
__device__ __forceinline__ void p8_final(const Args& a, LAS unsigned char* lds, int tid, int lane, int wave, int vcu, int G) {
    const bf16* X1 = (const bf16*)(a.ws + WS_H1); const unsigned char* YS = a.ws + WS_YS; const int* SLOTROW = (const int*)(a.ws + WS_SLOTROW);
    const float* STATS = (const float*)(a.ws + WS_STATS);
    typedef int p9i4 __attribute__((ext_vector_type(4))); typedef float f32x2_t __attribute__((ext_vector_type(2)));
    LAS f32x4* gl = (LAS f32x4*)lds;
    for (int u = tid; u < 512; u += NWAVES * 64) { gl[u] = ((const f32x4*)a.in[I_LN1G])[u]; gl[512 + u] = ((const f32x4*)a.in[I_LN1B])[u] * DN_ALPHA; gl[1024 + u] = ((const f32x4*)a.in[I_LN2G])[u]; gl[1536 + u] = ((const f32x4*)a.in[I_LN2B])[u]; }
    __syncthreads();
    const int gw = vcu * NWAVES + wave, NGW = G * NWAVES;
#define P9_SR(DST, ROW) do { const __attribute__((address_space(1))) p9i4* srp_ = (const __attribute__((address_space(1))) p9i4*)(SLOTROW + (size_t)(ROW) * 4); asm volatile("" : "+v"(srp_)); DST = *srp_; } while (0)
#define P9_ISSUE(ROW, SR, H, Y, M, R) do { const v2u* xp_ = (const v2u*)(X1 + (size_t)(ROW) * DM) + lane; M = STATS[2 * (ROW)]; R = STATS[2 * (ROW) + 1]; \
        _Pragma("unroll") for (int j = 0; j < 8; ++j) H[j] = xp_[64 * j]; \
        _Pragma("unroll") for (int k = 0; k < 4; ++k) { const unsigned* yp_ = (const unsigned*)(YS + (size_t)__builtin_amdgcn_readfirstlane(SR[k]) * DM) + lane; _Pragma("unroll") for (int j = 0; j < 8; ++j) Y[k][j] = yp_[64 * j]; } } while (0)
#define P9_COMPUTE(ROW, H, Y, M, R) do { f32x4 v[8]; \
        _Pragma("unroll") for (int j = 0; j < 8; ++j) { const f32x4 gg = gl[lane + 64 * j], bb = gl[512 + lane + 64 * j]; const v2u hw = H[j]; \
            v[j] = ((f32x4){bflo(hw.x), bfhi(hw.x), bflo(hw.y), bfhi(hw.y)} - M) * (R * DN_ALPHA) * gg + bb; } \
        __builtin_amdgcn_sched_barrier(0); \
        _Pragma("unroll") for (int k = 0; k < 4; ++k) { _Pragma("unroll") for (int j = 0; j < 8; ++j) { int w = (int)Y[k][j]; asm volatile("" : "+v"(w)); const f32x2_t lo = __builtin_amdgcn_cvt_pk_f32_fp8(w, false), hi = __builtin_amdgcn_cvt_pk_f32_fp8(w, true); \
                v[j][0] += lo[0] * (1.0f / YS_SCALE); v[j][1] += lo[1] * (1.0f / YS_SCALE); v[j][2] += hi[0] * (1.0f / YS_SCALE); v[j][3] += hi[1] * (1.0f / YS_SCALE); asm volatile("" : "+v"(v[j])); } } \
        float s = 0.f; \
        _Pragma("unroll") for (int j = 0; j < 8; ++j) s += (v[j][0] + v[j][1]) + (v[j][2] + v[j][3]); \
        const float mean = wave_sum(s) * (1.0f / DM); float q = 0.f; \
        _Pragma("unroll") for (int j = 0; j < 8; ++j) { v[j] = v[j] - mean; q += (v[j][0] * v[j][0] + v[j][1] * v[j][1]) + (v[j][2] * v[j][2] + v[j][3] * v[j][3]); } \
        const float rstd = 1.0f / sqrtf(wave_sum(q) * (1.0f / DM) + LN_EPS); \
        __builtin_amdgcn_sched_barrier(0); \
        f32x4* op = (f32x4*)(a.out + (size_t)(ROW) * DM) + lane; \
        _Pragma("unroll") for (int j = 0; j < 8; ++j) { const f32x4 gg = gl[1024 + lane + 64 * j], bb = gl[1536 + lane + 64 * j]; op[64 * j] = v[j] * rstd * gg + bb; } } while (0)
#define P9_NEXT(R_) (((R_) + NGW < NTOK) ? (R_) + NGW : (R_))
    int cur = gw; if (cur >= NTOK) return;
    v2u hA[8], hB[8]; unsigned yA[4][8], yB[4][8]; float mA, rA, mB, rB; p9i4 srA, srB;
    int n1 = P9_NEXT(cur), n2 = P9_NEXT(n1);
    P9_SR(srA, cur); P9_SR(srB, n1);
    P9_ISSUE(cur, srA, hA, yA, mA, rA);
    P9_SR(srA, n2); P9_ISSUE(n1, srB, hB, yB, mB, rB);
    asm volatile("" ::: "memory");
    P9_COMPUTE(cur, hA, yA, mA, rA);
    bool more = (n1 != cur);
    while (more) {
        cur = n1; n1 = n2; n2 = P9_NEXT(n1);
        P9_SR(srB, n2); P9_ISSUE(n1, srA, hA, yA, mA, rA);
        asm volatile("" ::: "memory");
        P9_COMPUTE(cur, hB, yB, mB, rB);
        if (n1 == cur) break;
        cur = n1; n1 = n2; n2 = P9_NEXT(n1);
        P9_SR(srA, n2); P9_ISSUE(n1, srB, hB, yB, mB, rB);
        asm volatile("" ::: "memory");
        P9_COMPUTE(cur, hA, yA, mA, rA);
        more = (n1 != cur);
    }
#undef P9_NEXT
#undef P9_ISSUE
#undef P9_SR
#undef P9_COMPUTE
}
typedef short bf16x8_t __attribute__((ext_vector_type(8)));
typedef short s16x4_t __attribute__((ext_vector_type(4)));
struct AttBlk { const bf16* q; const bf16* k; const bf16* v; long qstride, kstride; bf16* o; long ostride; float* lse; long lstride; int first; };
constexpr int NBLK_DIL = 3 * 8 * 6 * 32, NBLK_CROSS = 8 * 4 * 32;
__device__ __forceinline__ void p2b_combine(const Args& a, int lane, int wave, int vcu, int G) {
    const bf16* OATT = (const bf16*)(a.ws + WS_OATT); const float* LSE = (const float*)(a.ws + WS_LSE); bf16* Y = (bf16*)(a.ws + WS_Y);
    const int gw = vcu * NWAVES + wave, NGW = G * NWAVES;
#define P3_ISSUE(TOK, L, W, MY) do { \
        _Pragma("unroll") for (int j = 0; j < 3; ++j) { const int h = 2 * j + (lane >> 5), d = 4 * lane + 256 * j; \
            _Pragma("unroll") for (int p = 0; p < 3; ++p) { L[j][p] = LSE[((long)p * NTOK + (TOK)) * 6 + h]; W[j][p] = *(const v2u*)(OATT + ((long)p * NTOK + (TOK)) * 768 + d); } } \
        _Pragma("unroll") for (int j = 0; j < 2; ++j) MY[j] = *(const v2u*)(Y + (long)(TOK) * DM + 1536 + 4 * lane + 256 * j); } while (0)
#define P3_COMPUTE(TOK, L, W, MY) do { float o[3][4]; float ss = 0.f; \
        _Pragma("unroll") for (int j = 0; j < 3; ++j) { float l0 = L[j][0], l1 = L[j][1], l2 = L[j][2]; \
            const float m = fmaxf(l0, fmaxf(l1, l2)); l0 = __expf(l0 - m); l1 = __expf(l1 - m); l2 = __expf(l2 - m); const float inv = 1.0f / (l0 + l1 + l2); l0 *= inv; l1 *= inv; l2 *= inv; \
            const v2u w0 = W[j][0], w1 = W[j][1], w2 = W[j][2]; \
            o[j][0] = l0 * bflo(w0.x) + l1 * bflo(w1.x) + l2 * bflo(w2.x); o[j][1] = l0 * bfhi(w0.x) + l1 * bfhi(w1.x) + l2 * bfhi(w2.x); \
            o[j][2] = l0 * bflo(w0.y) + l1 * bflo(w1.y) + l2 * bflo(w2.y); o[j][3] = l0 * bfhi(w0.y) + l1 * bfhi(w1.y) + l2 * bfhi(w2.y); \
            ss += (o[j][0] * o[j][0] + o[j][1] * o[j][1]) + (o[j][2] * o[j][2] + o[j][3] * o[j][3]); } \
        const float rstd = 1.0f / sqrtf(wave_sum(ss) * (1.0f / 768.0f) + LN_EPS); \
        _Pragma("unroll") for (int j = 0; j < 3; ++j) { v2u w; w.x = pk2(o[j][0] * rstd, o[j][1] * rstd); w.y = pk2(o[j][2] * rstd, o[j][3] * rstd); *(v2u*)(Y + (long)(TOK) * DM + 768 + 4 * lane + 256 * j) = w; } \
        float m[2][4]; float sm = 0.f; \
        _Pragma("unroll") for (int j = 0; j < 2; ++j) { const v2u w = MY[j]; m[j][0] = bflo(w.x); m[j][1] = bfhi(w.x); m[j][2] = bflo(w.y); m[j][3] = bfhi(w.y); \
            sm += (m[j][0] * m[j][0] + m[j][1] * m[j][1]) + (m[j][2] * m[j][2] + m[j][3] * m[j][3]); } \
        const float rm = 1.0f / sqrtf(wave_sum(sm) * (1.0f / 512.0f) + LN_EPS); \
        _Pragma("unroll") for (int j = 0; j < 2; ++j) { v2u w; w.x = pk2(m[j][0] * rm, m[j][1] * rm); w.y = pk2(m[j][2] * rm, m[j][3] * rm); *(v2u*)(Y + (long)(TOK) * DM + 1536 + 4 * lane + 256 * j) = w; } } while (0)
#define P3_NEXT(R_) (((R_) + NGW < NTOK) ? (R_) + NGW : (R_))
    int cur = gw; if (cur >= NTOK) return;
    float lA[3][3], lB[3][3]; v2u wA[3][3], wB[3][3], yA[2], yB[2];
    int n1 = P3_NEXT(cur);
    P3_ISSUE(cur, lA, wA, yA);
    P3_ISSUE(n1, lB, wB, yB);
    asm volatile("" ::: "memory");
    P3_COMPUTE(cur, lA, wA, yA);
    bool more = (n1 != cur);
    while (more) {
        cur = n1; n1 = P3_NEXT(n1);
        P3_ISSUE(n1, lA, wA, yA);
        asm volatile("" ::: "memory");
        P3_COMPUTE(cur, lB, wB, yB);
        if (n1 == cur) break;
        cur = n1; n1 = P3_NEXT(n1);
        P3_ISSUE(n1, lB, wB, yB);
        asm volatile("" ::: "memory");
        P3_COMPUTE(cur, lA, wA, yA);
        more = (n1 != cur);
    }
#undef P3_NEXT
#undef P3_ISSUE
#undef P3_COMPUTE
}
constexpr int A2_VOFF = 65536;
__device__ __forceinline__ void a2_loadq(v4u (&qf)[4], const bf16* q, long qstride, int wave, int l15, int g) {
    const bf16* p = q + (long)(wave * 16 + l15) * qstride + g * 8;
    asm volatile("global_load_dwordx4 %0, %4, off\n\tglobal_load_dwordx4 %1, %4, off offset:64\n\tglobal_load_dwordx4 %2, %4, off offset:128\n\tglobal_load_dwordx4 %3, %4, off offset:192"
                 : "=&v"(qf[0]), "=&v"(qf[1]), "=&v"(qf[2]), "=&v"(qf[3]) : "v"(p) : "memory");
}
struct A3Blk { AttBlk B; int masked, p, ldprev, ldcur; };
__device__ __forceinline__ void a3_desc(const Args& a, int item, int pos, A3Blk& D) {
    const bf16* Z = (const bf16*)(a.ws + WS_Z); const bf16* MKV = (const bf16*)(a.ws + WS_MKV); bf16* Y = (bf16*)(a.ws + WS_Y); bf16* OATT = (bf16*)(a.ws + WS_OATT); float* LSE = (float*)(a.ws + WS_LSE);
    AttBlk& B = D.B; int pat, ci;
    if (item < 384) { pat = 0; ci = item; } else if (item < 768) { pat = 1; ci = item - 384; } else if (item < 1024) { pat = 3; ci = item - 768; } else { pat = 2; ci = item - 1024; }
    if (pat < 3) { int b, h, r, n;
        if (pat == 2) { b = ci / 96; const int rem = ci % 96; h = rem >> 4; r = rem & 15; n = pos; }
        else { b = ci / 48; const int rem = ci % 48; h = rem >> 3; const int c8 = rem & 7; if (pat == 0) { r = 0; n = c8 * 4 + pos; } else { r = c8 >> 1; n = (c8 & 1) * 4 + pos; } }
        const int dil = 1 << (2 * pat); const long tq = (long)b * SEQ + (long)128 * n * dil + r, tk = tq - (long)128 * dil;
        B.q = Z + tq * DPJ + ZQ + h * 128; B.k = Z + tk * DPJ + ZK + h * 128; B.v = Z + tk * DPJ + ZW + h * 128; B.qstride = (long)dil * DPJ; B.kstride = (long)dil * DPJ;
        B.o = OATT + ((long)pat * NTOK + tq) * 768 + h * 128; B.ostride = (long)dil * 768; B.lse = LSE + ((long)pat * NTOK + tq) * 6 + h; B.lstride = (long)dil * 6; B.first = (n == 0);
        D.masked = 1; D.p = pos; D.ldprev = (pos == 0); D.ldcur = 1; }
    else { const int b = ci >> 5, h = (ci >> 3) & 3, n = (ci & 7) * 4 + pos; const long tq = (long)b * SEQ + 128 * n;
        B.q = Z + tq * DPJ + ZM + h * 128; B.k = MKV + (long)b * NMEM * 1024 + h * 128; B.v = B.k + 512; B.qstride = DPJ; B.kstride = 1024;
        B.o = Y + tq * DM + 1536 + h * 128; B.ostride = DM; B.lse = nullptr; B.lstride = 0; B.first = 0;
        D.masked = 0; D.p = 0; D.ldprev = (pos == 0); D.ldcur = (pos == 0); }
}
__device__ __forceinline__ int a3_chainlen(int item) { return (item >= 1024) ? 2 : 4; }
template <bool KIMG>
__device__ __forceinline__ void a3_stage_half(LAS unsigned char* img, const bf16* base, long stride, int first, int half, int slot, int lane, int wave) {
    const int rlo = lane >> 4, cp = lane & 15;
#pragma unroll
    for (int i = 0; i < 4; ++i) { const int row = half * 128 + (wave * 4 + i) * 4 + rlo, rr = (first && row < 128) ? 128 : row; const int ch = cp ^ (KIMG ? (((i & 3) << 2) | rlo) : ((rlo << 2) | (i & 3)));
        __builtin_amdgcn_global_load_lds((const unsigned*)(base + (long)rr * stride + ch * 8), (LAS unsigned*)(img + slot * 32768 + (wave * 4 + i) * 1024), 16, 0, 0); }
}
template <bool KIMG>
__device__ __forceinline__ void a3_stage(LAS unsigned char* img, const bf16* base, const A3Blk& D, int lane, int wave) {
    if (D.ldprev) a3_stage_half<KIMG>(img, base, D.B.kstride, D.B.first, 0, D.p & 1, lane, wave);
    if (D.ldcur) a3_stage_half<KIMG>(img, base, D.B.kstride, D.B.first, 1, (D.p + 1) & 1, lane, wave);
}
#define A3_TILE(kt, p) (((((kt) >> 3) + (p)) & 1) * 32768 + ((kt) & 7) * 4096)
template <bool MASKED>
__device__ __forceinline__ void a3_qk(LAS unsigned char* lds, const v4u (&qf)[4], f32x4 (&st)[16], int p, int wave, int l15, int g) {
    constexpr int NT = MASKED ? 9 : 16; const int x = l15;
    int koff[4];
#pragma unroll
    for (int ds = 0; ds < 4; ++ds) koff[ds] = 256 * l15 + 16 * ((4 * ds + g) ^ x);
    bf16x8_t kA[2][4], kB[2][4];
#define A3_KLOAD2(DST, I_) do { _Pragma("unroll") for (int u_ = 0; u_ < 2; ++u_) if ((I_) + u_ < NT) { const int kt_ = MASKED ? min(wave + (I_) + u_, 15) : (I_) + u_; const int tb_ = A3_TILE(kt_, p); \
        _Pragma("unroll") for (int ds = 0; ds < 4; ++ds) DST[u_][ds] = *(const LAS bf16x8_t*)(lds + tb_ + koff[ds]); } } while (0)
#define A3_KMMA2(SRC, I_) do { f32x4 a0_ = {0.f, 0.f, 0.f, 0.f}, a1_ = {0.f, 0.f, 0.f, 0.f}; \
        _Pragma("unroll") for (int ds = 0; ds < 4; ++ds) { a0_ = __builtin_amdgcn_mfma_f32_16x16x32_bf16(SRC[0][ds], __builtin_bit_cast(bf16x8_t, qf[ds]), a0_, 0, 0, 0); \
            if ((I_) + 1 < NT) a1_ = __builtin_amdgcn_mfma_f32_16x16x32_bf16(SRC[1][ds], __builtin_bit_cast(bf16x8_t, qf[ds]), a1_, 0, 0, 0); } \
        st[(I_)] = a0_; if ((I_) + 1 < NT) st[(I_) + 1] = a1_; } while (0)
    A3_KLOAD2(kA, 0);
#pragma unroll
    for (int ip = 0; ip < NT; ip += 4) {
        if (ip + 2 < NT) A3_KLOAD2(kB, ip + 2);
        __builtin_amdgcn_sched_barrier(0);
        A3_KMMA2(kA, ip);
        if (ip + 2 < NT) {
            if (ip + 4 < NT) A3_KLOAD2(kA, ip + 4);
            __builtin_amdgcn_sched_barrier(0);
            A3_KMMA2(kB, ip + 2); }
        __builtin_amdgcn_sched_barrier(0);
    }
#undef A3_KLOAD2
#undef A3_KMMA2
}
template <bool MASKED>
__device__ __forceinline__ void a3_softmax_pv(LAS unsigned char* lds, f32x4 (&st)[16], const AttBlk& B, int p, int wave, int lane, int l15, int g) {
    constexpr int NT = MASKED ? 10 : 16, NTQ = MASKED ? 9 : 16;
    float mx = -INFINITY;
    if (MASKED) { const int qi = wave * 16 + l15;
#pragma unroll
        for (int j = 0; j < 4; ++j) { if ((wave + 0) * 16 + 4 * g + j < qi) st[0][j] = -INFINITY; if ((wave + 8) * 16 + 4 * g + j > qi + 128 || wave + 8 > 15) st[8][j] = -INFINITY; }
        if (B.first) {
#pragma unroll
            for (int i = 0; i < NTQ; ++i) if (wave + i < 8) st[i] = (f32x4){-INFINITY, -INFINITY, -INFINITY, -INFINITY}; } }
#pragma unroll
    for (int i = 0; i < NTQ; ++i) mx = fmaxf(mx, fmaxf(fmaxf(st[i][0], st[i][1]), fmaxf(st[i][2], st[i][3])));
    mx = fmaxf(mx, __shfl_xor(mx, 16)); mx = fmaxf(mx, __shfl_xor(mx, 32));
    constexpr float C2 = ATT_SCALE * 1.4426950408889634f; unsigned pp[NT][2];
    typedef float f32x2_t __attribute__((ext_vector_type(2))); typedef __bf16 bf16x2_t __attribute__((ext_vector_type(2)));
    const float mxc = -mx * C2; f32x2_t sum2 = {0.f, 0.f};
#pragma unroll
    for (int i = 0; i < NTQ; ++i) { const f32x2_t a = (f32x2_t){st[i][0], st[i][1]} * C2 + mxc, b = (f32x2_t){st[i][2], st[i][3]} * C2 + mxc;
        f32x2_t pa, pb; pa.x = __builtin_amdgcn_exp2f(a.x); pa.y = __builtin_amdgcn_exp2f(a.y); pb.x = __builtin_amdgcn_exp2f(b.x); pb.y = __builtin_amdgcn_exp2f(b.y);
        sum2 += pa; sum2 += pb;
        pp[i][0] = __builtin_bit_cast(unsigned, __builtin_convertvector(pa, bf16x2_t)); pp[i][1] = __builtin_bit_cast(unsigned, __builtin_convertvector(pb, bf16x2_t)); }
    float sum = sum2.x + sum2.y;
    if (MASKED) { pp[NT - 1][0] = 0u; pp[NT - 1][1] = 0u; }
    sum += __shfl_xor(sum, 16); sum += __shfl_xor(sum, 32);
    f32x4 oacc[8];
#pragma unroll
    for (int c = 0; c < 8; ++c) oacc[c] = (f32x4){0.f, 0.f, 0.f, 0.f};
    const int q4 = l15 >> 2, p4 = lane & 3; const int xv = (q4 << 2) | g;
    unsigned ldsb = (unsigned)(size_t)lds; asm volatile("" : "+v"(ldsb));
    unsigned voff[8];
#pragma unroll
    for (int c = 0; c < 8; ++c) voff[c] = 256 * (4 * g + q4) + 16 * ((2 * c + (p4 >> 1)) ^ xv) + 8 * (p4 & 1);
    constexpr int NG = NT;
    s16x4_t lo[2][4], hi[2][4];
#define A3_READS(i) do { const int s_ = (i) >> 1, ch_ = (i) & 1; const int ta_ = MASKED ? min(wave + 2 * s_, 15) : 2 * s_, tb_ = MASKED ? min(wave + 2 * s_ + 1, 15) : 2 * s_ + 1; \
        unsigned va_ = ldsb + A2_VOFF + A3_TILE(ta_, p), vb_ = ldsb + A2_VOFF + A3_TILE(tb_, p); asm volatile("" : "+v"(va_), "+v"(vb_)); \
        asm volatile("ds_read_b64_tr_b16 %0, %8\n\tds_read_b64_tr_b16 %1, %9\n\tds_read_b64_tr_b16 %2, %10\n\tds_read_b64_tr_b16 %3, %11\n\tds_read_b64_tr_b16 %4, %12\n\tds_read_b64_tr_b16 %5, %13\n\tds_read_b64_tr_b16 %6, %14\n\tds_read_b64_tr_b16 %7, %15" \
                     : "=&v"(lo[(i) & 1][0]), "=&v"(hi[(i) & 1][0]), "=&v"(lo[(i) & 1][1]), "=&v"(hi[(i) & 1][1]), "=&v"(lo[(i) & 1][2]), "=&v"(hi[(i) & 1][2]), "=&v"(lo[(i) & 1][3]), "=&v"(hi[(i) & 1][3]) \
                     : "v"(va_ + voff[4 * ch_ + 0]), "v"(vb_ + voff[4 * ch_ + 0]), "v"(va_ + voff[4 * ch_ + 1]), "v"(vb_ + voff[4 * ch_ + 1]), "v"(va_ + voff[4 * ch_ + 2]), "v"(vb_ + voff[4 * ch_ + 2]), "v"(va_ + voff[4 * ch_ + 3]), "v"(vb_ + voff[4 * ch_ + 3]) : "memory"); } while (0)
    A3_READS(0);
#pragma unroll
    for (int i = 0; i < NG; ++i) { __builtin_amdgcn_sched_barrier(0);
        if (i + 1 < NG) { A3_READS(i + 1);
            asm volatile("s_waitcnt lgkmcnt(8)" : "+v"(lo[i & 1][0]), "+v"(hi[i & 1][0]), "+v"(lo[i & 1][1]), "+v"(hi[i & 1][1]), "+v"(lo[i & 1][2]), "+v"(hi[i & 1][2]), "+v"(lo[i & 1][3]), "+v"(hi[i & 1][3]) :: "memory"); }
        else asm volatile("s_waitcnt lgkmcnt(0)" : "+v"(lo[i & 1][0]), "+v"(hi[i & 1][0]), "+v"(lo[i & 1][1]), "+v"(hi[i & 1][1]), "+v"(lo[i & 1][2]), "+v"(hi[i & 1][2]), "+v"(lo[i & 1][3]), "+v"(hi[i & 1][3]) :: "memory");
        const int s = i >> 1, ch = i & 1; const bf16x8_t pf = __builtin_bit_cast(bf16x8_t, (v4u){pp[2 * s][0], pp[2 * s][1], pp[2 * s + 1][0], pp[2 * s + 1][1]});
#pragma unroll
        for (int c = 0; c < 4; ++c) { const bf16x8_t vf = {lo[i & 1][c][0], lo[i & 1][c][1], lo[i & 1][c][2], lo[i & 1][c][3], hi[i & 1][c][0], hi[i & 1][c][1], hi[i & 1][c][2], hi[i & 1][c][3]};
            oacc[4 * ch + c] = __builtin_amdgcn_mfma_f32_16x16x32_bf16(vf, pf, oacc[4 * ch + c], 0, 0, 0); } }
#undef A3_READS
    const float inv = 1.0f / sum; bf16* op = B.o + (long)(wave * 16 + l15) * B.ostride + 4 * g;
#pragma unroll
    for (int c = 0; c < 8; ++c) { v2u w; w.x = pk2(oacc[c][0] * inv, oacc[c][1] * inv); w.y = pk2(oacc[c][2] * inv, oacc[c][3] * inv); *(v2u*)(op + 16 * c) = w; }
    if (MASKED && g == 0) B.lse[(long)(wave * 16 + l15) * B.lstride] = mx * ATT_SCALE + __logf(sum);
}
__device__ __forceinline__ int a3_item(int vcu, int G, int slot) {
    if (G != 256) return vcu + slot * G;
    if (slot > 6) return 1 << 20;
    const int b = vcu >> 5, i = vcu & 31, m = i & 15;
    if (slot == 6) return 768 + b * 32 + i;
    const bool four = ((slot & 1) == 0) == (i < 16);
    return four ? ((m < 8 ? 0 : 384) + b * 48 + slot * 8 + (m & 7)) : (1024 + b * 96 + slot * 16 + m);
}
__device__ __forceinline__ void p2_attn_chain(const Args& a, LAS unsigned char* lds, int tid, int lane, int wave, int vcu, int G) {
    const int l15 = lane & 15, g = lane >> 4; constexpr int NITEM = 1792;
    int slot = 0, item = a3_item(vcu, G, 0), pos = 0; if (item >= NITEM) return;
    A3Blk D, Dn; a3_desc(a, item, pos, D);
    v4u qf[4]; f32x4 st[16];
    a3_stage<true>(lds, D.B.k, D, lane, wave); a2_loadq(qf, D.B.q, D.B.qstride, wave, l15, g);
    asm volatile("s_waitcnt vmcnt(0)" ::: "memory"); __builtin_amdgcn_s_barrier(); asm volatile("" ::: "memory");
    a3_stage<false>(lds + A2_VOFF, D.B.v, D, lane, wave);
    for (;;) {
        int itemn = item, posn = pos + 1; if (posn >= a3_chainlen(item)) { itemn = a3_item(vcu, G, ++slot); posn = 0; }
        const bool has_next = itemn < NITEM; if (has_next) a3_desc(a, itemn, posn, Dn);
        if (D.masked) a3_qk<true>(lds, qf, st, D.p, wave, l15, g); else a3_qk<false>(lds, qf, st, D.p, wave, l15, g);
        asm volatile("s_waitcnt vmcnt(0)" ::: "memory"); __builtin_amdgcn_s_barrier(); asm volatile("" ::: "memory");
        if (has_next) { a3_stage<true>(lds, Dn.B.k, Dn, lane, wave); a2_loadq(qf, Dn.B.q, Dn.B.qstride, wave, l15, g); }
        if (D.masked) { a3_softmax_pv<true>(lds, st, D.B, D.p, wave, lane, l15, g); asm volatile("s_waitcnt vmcnt(9)" ::: "memory"); }
        else { a3_softmax_pv<false>(lds, st, D.B, D.p, wave, lane, l15, g); asm volatile("s_waitcnt vmcnt(8)" ::: "memory"); }
        asm volatile("s_waitcnt lgkmcnt(0)" ::: "memory"); __builtin_amdgcn_s_barrier(); asm volatile("" ::: "memory");
        if (!has_next) break;
        a3_stage<false>(lds + A2_VOFF, Dn.B.v, Dn, lane, wave);
        D = Dn; item = itemn; pos = posn;
    }
    asm volatile("s_waitcnt vmcnt(0)" ::: "memory"); __builtin_amdgcn_s_barrier();
}
constexpr int SGU_P = 800, SGU_STAT = 128 * SGU_P;
__device__ __forceinline__ void sgu_unit_mfma(const Args& a, LAS unsigned char* lds, int unit, int tid, int lane, int wave) {
    const bf16* Z = (const bf16*)(a.ws + WS_Z); bf16* Y = (bf16*)(a.ws + WS_Y);
    const float* __restrict__ wsp = a.in[I_WSP]; const float* __restrict__ bsp = a.in[I_BSP]; const float* lng = a.in[I_ALNG]; const float* lnb = a.in[I_ALNB];
    const int tok0 = unit * 128;
    LAS float* stat = (LAS float*)(lds + SGU_STAT);
    {
        const int tk = wave * 16 + (lane >> 2); const v4u* vp = (const v4u*)(Z + (size_t)(tok0 + tk) * DPJ + ZV + (lane & 3) * 192); float s = 0.f, q = 0.f;
#pragma unroll
        for (int hf = 0; hf < 2; ++hf) { v4u w[12];
#pragma unroll
            for (int j = 0; j < 12; ++j) w[j] = vp[12 * hf + j];
#pragma unroll
            for (int j = 0; j < 12; ++j)
#pragma unroll
                for (int e = 0; e < 4; ++e) { const float x0 = bflo(w[j][e]), x1 = bfhi(w[j][e]); s += x0 + x1; q = fmaf(x0, x0, fmaf(x1, x1, q)); } }
        s += __shfl_xor(s, 1); s += __shfl_xor(s, 2); q += __shfl_xor(q, 1); q += __shfl_xor(q, 2);
        const float mean = s * (1.0f / 768.0f), rstd = 1.0f / sqrtf(fmaxf(q * (1.0f / 768.0f) - mean * mean, 0.f) + LN_EPS);
        if ((lane & 3) == 0) { stat[2 * tk] = mean; stat[2 * tk + 1] = rstd; } }
    __syncthreads();
    const int l15 = lane & 15, g4 = lane >> 4, q4 = l15 >> 2, p4 = lane & 3;
    const int t = wave * 16 + l15, ksmax = wave >> 1;
    float ss = 0.f; bf16* yo = Y + (size_t)(tok0 + t) * DM + 4 * g4;
#pragma unroll 1
    for (int r = 0; r < 2; ++r) {
#pragma unroll 1
        for (int ib = 0; ib < 24; ib += 8) { v2u zw[8]; f32x4 gv[8], bv[8];
#pragma unroll
            for (int j = 0; j < 8; ++j) { const int idx = tid + 512 * (ib + j), s = idx / 96, c4 = (idx - s * 96) * 4;
                zw[j] = *(const v2u*)(Z + (size_t)(tok0 + s) * DPJ + ZV + r * 384 + c4); gv[j] = *(const f32x4*)(lng + r * 384 + c4); bv[j] = *(const f32x4*)(lnb + r * 384 + c4); }
            asm volatile("" ::: "memory");
#pragma unroll
            for (int j = 0; j < 8; ++j) { const int idx = tid + 512 * (ib + j), s = idx / 96, c4 = (idx - s * 96) * 4;
                const v2u w = zw[j]; const float mean = stat[2 * s], rstd = stat[2 * s + 1]; const f32x4 gg = gv[j], bb = bv[j];
                v2u o; o.x = pk2((bflo(w.x) - mean) * rstd * gg[0] + bb[0], (bfhi(w.x) - mean) * rstd * gg[1] + bb[1]); o.y = pk2((bflo(w.y) - mean) * rstd * gg[2] + bb[2], (bfhi(w.y) - mean) * rstd * gg[3] + bb[3]);
                *(LAS v2u*)(lds + s * SGU_P + c4 * 2) = o; } }
        __syncthreads();
#pragma unroll 1
        for (int gi = 0; gi < 3; ++gi) { const int g = 3 * r + gi;
            f32x4 acc[8];
#pragma unroll
            for (int ct = 0; ct < 8; ++ct) acc[ct] = (f32x4){0.f, 0.f, 0.f, 0.f};
            const float* Wrow = wsp + (size_t)g * 16384 + t * 128 + 8 * g4;
            f32x4 wA[4], wB[4];
#pragma unroll
            for (int ks = 0; ks < 4; ++ks) { wA[ks] = (f32x4){0.f, 0.f, 0.f, 0.f}; wB[ks] = wA[ks]; if (ks <= ksmax) { wA[ks] = *(const f32x4*)(Wrow + 32 * ks); wB[ks] = *(const f32x4*)(Wrow + 32 * ks + 4); } }
            const bf16* up = Z + (size_t)(tok0 + t) * DPJ + ZU + g * 128 + 4 * g4; v2u uu8[8];
#pragma unroll
            for (int ct = 0; ct < 8; ++ct) uu8[ct] = *(const v2u*)(up + 16 * ct);
            const float bias = bsp[g * 128 + t];
#pragma unroll
            for (int ks = 0; ks < 4; ++ks) { if (ks <= ksmax) { const int s0 = 32 * ks + 8 * g4; const f32x4 wa = wA[ks], wb = wB[ks];
                v4u wp; wp.x = pk2(s0 <= t ? wa[0] : 0.f, s0 + 1 <= t ? wa[1] : 0.f); wp.y = pk2(s0 + 2 <= t ? wa[2] : 0.f, s0 + 3 <= t ? wa[3] : 0.f);
                wp.z = pk2(s0 + 4 <= t ? wb[0] : 0.f, s0 + 5 <= t ? wb[1] : 0.f); wp.w = pk2(s0 + 6 <= t ? wb[2] : 0.f, s0 + 7 <= t ? wb[3] : 0.f);
                const bf16x8_t wf = __builtin_bit_cast(bf16x8_t, wp);
                const LAS unsigned char* vp = lds + (32 * ks + 8 * g4 + q4) * SGU_P + gi * 256 + 8 * p4;
#pragma unroll
                for (int ct = 0; ct < 8; ++ct) { const s16x4_t lo = __builtin_bit_cast(s16x4_t, __builtin_amdgcn_ds_read_tr16_b64_v4i16((LAS s16x4_t*)(vp + 32 * ct))), hi = __builtin_bit_cast(s16x4_t, __builtin_amdgcn_ds_read_tr16_b64_v4i16((LAS s16x4_t*)(vp + 4 * SGU_P + 32 * ct)));
                    const bf16x8_t vf = {lo[0], lo[1], lo[2], lo[3], hi[0], hi[1], hi[2], hi[3]};
                    acc[ct] = __builtin_amdgcn_mfma_f32_16x16x32_bf16(vf, wf, acc[ct], 0, 0, 0); } } }
#pragma unroll
            for (int ct = 0; ct < 8; ++ct) { const v2u uu = uu8[ct];
                const float y0 = bflo(uu.x) * (acc[ct][0] + bias), y1 = bfhi(uu.x) * (acc[ct][1] + bias), y2 = bflo(uu.y) * (acc[ct][2] + bias), y3 = bfhi(uu.y) * (acc[ct][3] + bias);
                ss += (y0 * y0 + y1 * y1) + (y2 * y2 + y3 * y3); v2u yw; yw.x = pk2(y0, y1); yw.y = pk2(y2, y3); *(v2u*)(yo + g * 128 + 16 * ct) = yw; } }
        __syncthreads();
    }
    ss += __shfl_xor(ss, 16); ss += __shfl_xor(ss, 32);
    const float rs = 1.0f / sqrtf(ss * (1.0f / 768.0f) + LN_EPS);
    asm volatile("s_waitcnt vmcnt(0)" ::: "memory");
#pragma unroll 1
    for (int g2 = 0; g2 < 3; ++g2) { v2u yr[16];
#pragma unroll
        for (int i = 0; i < 16; ++i) yr[i] = *(const v2u*)(yo + (2 * g2 + (i >> 3)) * 128 + 16 * (i & 7));
        asm volatile("" ::: "memory");
#pragma unroll
        for (int i = 0; i < 16; ++i) { v2u w; w.x = pk2(bflo(yr[i].x) * rs, bfhi(yr[i].x) * rs); w.y = pk2(bflo(yr[i].y) * rs, bfhi(yr[i].y) * rs); *(v2u*)(yo + (2 * g2 + (i >> 3)) * 128 + 16 * (i & 7)) = w; } }
}
__device__ __forceinline__ void p5_ln1_router_wave(const Args& a, LAS unsigned char* lds, int tid, int lane, int wave, int vcu, int G, int probe) {
    const bf16* H1 = (const bf16*)(a.ws + WS_H1); unsigned char* X1Q = a.ws + WS_X1Q; unsigned* ctl = (unsigned*)(a.ws + WS_CTL);
    int* LIST = (int*)(a.ws + (probe ? WS_XS + 256 * MiB : WS_LIST)); float* GATEL = (float*)(a.ws + (probe ? WS_XS + 260 * MiB : WS_GATEL)); const int cwc = probe ? CW_CNT + 4096 : CW_CNT;
    float* STATS = (float*)(a.ws + WS_STATS); const bf16* WRB = (const bf16*)(a.ws + WS_WRF); const float* C12 = (const float*)(a.ws + WS_WRF + 512 * 1024); const bf16* GB16 = (const bf16*)(a.ws + WS_WRF + 768 * 1024);
    const int l15 = lane & 15, g4 = lane >> 4;
    LAS unsigned* cntl = (LAS unsigned*)lds; LAS unsigned* basel = cntl + 32;
    if (tid < 32) cntl[tid] = 0u;
    asm volatile("s_waitcnt lgkmcnt(0)" ::: "memory"); __builtin_amdgcn_s_barrier(); asm volatile("" ::: "memory");
    constexpr int P5_GB = 1024 + 131072;
    { const v4u* gsrc = (const v4u*)GB16; for (int u = tid; u < 512; u += NWAVES * 64) *(LAS v4u*)(lds + P5_GB + 16 * u) = gsrc[u]; }
    for (int wgt = vcu; wgt < NTOK / 128; wgt += G) { const int grp = wgt * NWAVES + wave; const int row0 = grp * 16;
        const bf16* hp = H1 + (size_t)(row0 + l15) * DM + 8 * g4; const bf16* wp = WRB + lane * 8;
        f32x4 acc0 = {0.f, 0.f, 0.f, 0.f}, acc1 = {0.f, 0.f, 0.f, 0.f}; float s1 = 0.f, s2 = 0.f;
        constexpr int P5_WB = 1024;
#define P5_STAGE(C_, BUF_) do { _Pragma("unroll") for (int i_ = 0; i_ < 8; ++i_) __builtin_amdgcn_global_load_lds((const unsigned*)((const unsigned char*)WRB + (size_t)(C_) * 65536 + (wave * 8 + i_) * 1024 + lane * 16), \
            (LAS unsigned*)(lds + P5_WB + (BUF_) * 65536 + (wave * 8 + i_) * 1024), 16, 0, 0); } while (0)
#define P5_LOADH(C_, HALF_, H) do { _Pragma("unroll") for (int i_ = 0; i_ < 8; ++i_) H[i_] = *(const v4u*)(hp + 32 * (16 * (C_) + 8 * (HALF_) + i_)); } while (0)
#define P5_HALF(BUF_, HALF_, H) do { unsigned wl_ = (unsigned)(size_t)(lds + P5_WB + (BUF_) * 65536 + (HALF_) * 32768) + lane * 16; \
        _Pragma("unroll") for (int i_ = 0; i_ < 8; ++i_) { const v4u hw = H[i_]; v4u w0h, w0l, w1h, w1l; \
            asm volatile("ds_read_b128 %0, %4\n\tds_read_b128 %1, %4 offset:1024\n\tds_read_b128 %2, %4 offset:2048\n\tds_read_b128 %3, %4 offset:3072\n\ts_waitcnt lgkmcnt(0)" \
                         : "=&v"(w0h), "=&v"(w0l), "=&v"(w1h), "=&v"(w1l) : "v"(wl_ + i_ * 4096) : "memory");       \
            const bf16x8_t af = __builtin_bit_cast(bf16x8_t, hw); \
            acc0 = __builtin_amdgcn_mfma_f32_16x16x32_bf16(af, __builtin_bit_cast(bf16x8_t, w0h), acc0, 0, 0, 0); acc0 = __builtin_amdgcn_mfma_f32_16x16x32_bf16(af, __builtin_bit_cast(bf16x8_t, w0l), acc0, 0, 0, 0); \
            acc1 = __builtin_amdgcn_mfma_f32_16x16x32_bf16(af, __builtin_bit_cast(bf16x8_t, w1h), acc1, 0, 0, 0); acc1 = __builtin_amdgcn_mfma_f32_16x16x32_bf16(af, __builtin_bit_cast(bf16x8_t, w1l), acc1, 0, 0, 0); \
            _Pragma("unroll") for (int q = 0; q < 4; ++q) { const float x0 = bflo(hw[q]), x1 = bfhi(hw[q]); s1 += x0 + x1; s2 = fmaf(x0, x0, fmaf(x1, x1, s2)); } } } while (0)
#define P5_BAR() do { asm volatile("" ::: "memory"); __builtin_amdgcn_s_barrier(); asm volatile("" ::: "memory"); } while (0)
#define P5_F() asm volatile("" ::: "memory")
        { v4u hA[8], hB[8];
          P5_STAGE(0, 0); P5_STAGE(1, 1); P5_LOADH(0, 0, hA);
          asm volatile("s_waitcnt vmcnt(0)" ::: "memory"); P5_BAR();
          P5_LOADH(0, 1, hB); P5_F(); P5_HALF(0, 0, hA); P5_LOADH(1, 0, hA); P5_F(); P5_HALF(0, 1, hB);
          P5_BAR(); P5_STAGE(2, 0);
          P5_LOADH(1, 1, hB); P5_F(); P5_HALF(1, 0, hA); P5_LOADH(2, 0, hA); P5_F(); P5_HALF(1, 1, hB);
          P5_BAR(); P5_STAGE(3, 1);
          asm volatile("s_waitcnt vmcnt(8)" ::: "memory"); P5_BAR();
          P5_LOADH(2, 1, hB); P5_F(); P5_HALF(0, 0, hA); P5_LOADH(3, 0, hA); P5_F(); P5_HALF(0, 1, hB);
          asm volatile("s_waitcnt vmcnt(0)" ::: "memory"); P5_BAR();
          P5_LOADH(3, 1, hB); P5_F(); P5_HALF(1, 0, hA); P5_HALF(1, 1, hB);
          P5_BAR(); }
#undef P5_F
#undef P5_HALF
#undef P5_STAGE
#undef P5_LOADH
#undef P5_BAR
        s1 += __shfl_xor(s1, 16); s1 += __shfl_xor(s1, 32); s2 += __shfl_xor(s2, 16); s2 += __shfl_xor(s2, 32);
        const float mean = s1 * (1.0f / DM), rstd = 1.0f / sqrtf(fmaxf(s2 * (1.0f / DM) - mean * mean, 0.f) + LN_EPS);
        const float c1a = C12[l15], c1b = C12[16 + l15], c2a = C12[32 + l15], c2b = C12[48 + l15];
        float va[4], vb[4];
#pragma unroll
        for (int j = 0; j < 4; ++j) { const float mj = __shfl(mean, 4 * g4 + j), rj = __shfl(rstd, 4 * g4 + j); va[j] = rj * (acc0[j] - mj * c1a) + c2a; vb[j] = rj * (acc1[j] - mj * c1b) + c2b; }
        float tv[4][4]; int ti[4][4];
#pragma unroll
        for (int r = 0; r < 4; ++r)
#pragma unroll
            for (int j = 0; j < 4; ++j) { float bv = va[j]; int bi = l15; if (vb[j] > bv) { bv = vb[j]; bi = 16 + l15; }
#pragma unroll
                for (int o = 1; o < 16; o <<= 1) { const float ov = __shfl_xor(bv, o); const int oi = __shfl_xor(bi, o); if (ov > bv || (ov == bv && oi < bi)) { bv = ov; bi = oi; } }
                tv[r][j] = bv; ti[r][j] = bi; if (bi == l15) va[j] = -INFINITY; if (bi == 16 + l15) vb[j] = -INFINITY; }
        int mye[4]; float myg[4]; unsigned myr[4];
#pragma unroll
        for (int j = 0; j < 4; ++j) { const float e1 = __expf(tv[1][j] - tv[0][j]), e2 = __expf(tv[2][j] - tv[0][j]), e3 = __expf(tv[3][j] - tv[0][j]); const float inv = 1.0f / (1.0f + e1 + e2 + e3);
            mye[j] = l15 == 0 ? ti[0][j] : (l15 == 1 ? ti[1][j] : (l15 == 2 ? ti[2][j] : ti[3][j])); myg[j] = (l15 == 0 ? 1.0f : (l15 == 1 ? e1 : (l15 == 2 ? e2 : e3))) * inv; myr[j] = 0u;
            if (l15 < 4) myr[j] = __hip_atomic_fetch_add(cntl + mye[j], 1u, __ATOMIC_RELAXED, __HIP_MEMORY_SCOPE_WORKGROUP); }
        asm volatile("s_waitcnt lgkmcnt(0)" ::: "memory"); __builtin_amdgcn_s_barrier(); asm volatile("" ::: "memory");
        if (tid < 32) { const unsigned n = cntl[tid]; basel[tid] = n ? atomicAdd(ctl + cwc + 64 * tid, n) : 0u; }
        asm volatile("s_waitcnt vmcnt(0) lgkmcnt(0)" ::: "memory"); __builtin_amdgcn_s_barrier(); asm volatile("" ::: "memory");
        if (l15 < 4) {
#pragma unroll
            for (int j = 0; j < 4; ++j) { const int row = row0 + 4 * g4 + j; const unsigned rank = basel[mye[j]] + myr[j]; LIST[(size_t)mye[j] * NTOK + rank] = row * 4 + l15; GATEL[(size_t)mye[j] * NTOK + rank] = myg[j]; } }
        asm volatile("s_waitcnt lgkmcnt(0)" ::: "memory"); __builtin_amdgcn_s_barrier(); asm volatile("" ::: "memory");
        if (tid < 32) cntl[tid] = 0u;
        asm volatile("s_waitcnt lgkmcnt(0)" ::: "memory"); __builtin_amdgcn_s_barrier(); asm volatile("" ::: "memory");
        if (g4 == 0) { STATS[2 * (row0 + l15)] = mean; STATS[2 * (row0 + l15) + 1] = rstd; }
        unsigned char* xo = X1Q + (size_t)(row0 + l15) * DM + 8 * g4; const float rs8 = rstd * XS_SCALE; const LAS unsigned char* gpl = lds + P5_GB + 16 * g4;
#pragma unroll 1
        for (int sb = 0; sb < 4; ++sb) { v4u hq[16];
#pragma unroll
            for (int i = 0; i < 16; ++i) hq[i] = *(const v4u*)(hp + 32 * (16 * sb + i));
#pragma unroll
            for (int i = 0; i < 16; ++i) { const int s = 16 * sb + i; const v4u hw = hq[i], gg = *(const LAS v4u*)(gpl + 64 * s), bb = *(const LAS v4u*)(gpl + 4096 + 64 * s);
                v2u o; o.x = pk4_fp8((bflo(hw.x) - mean) * rs8 * bflo(gg.x) + bflo(bb.x), (bfhi(hw.x) - mean) * rs8 * bfhi(gg.x) + bfhi(bb.x), (bflo(hw.y) - mean) * rs8 * bflo(gg.y) + bflo(bb.y), (bfhi(hw.y) - mean) * rs8 * bfhi(gg.y) + bfhi(bb.y));
                o.y = pk4_fp8((bflo(hw.z) - mean) * rs8 * bflo(gg.z) + bflo(bb.z), (bfhi(hw.z) - mean) * rs8 * bfhi(gg.z) + bfhi(bb.z), (bflo(hw.w) - mean) * rs8 * bflo(gg.w) + bflo(bb.w), (bfhi(hw.w) - mean) * rs8 * bfhi(gg.w) + bfhi(bb.w));
                *(v2u*)(xo + 32 * s) = o; } }
    }
}
constexpr int NPHASE = 10;
__global__ void __launch_bounds__(NWAVES * 64, 2) fwd_kernel(Args args) {
    extern __shared__ __attribute__((aligned(16))) unsigned char lds_raw[];
    LAS unsigned char* lds = (LAS unsigned char*)lds_raw;
#define FRESH_IDS() int tid = threadIdx.x; asm volatile("" : "+v"(tid)); const int lane = tid & 63, wave = __builtin_amdgcn_readfirstlane(tid >> 6)
    const int G = gridDim.x; const int bx = blockIdx.x; const int vcu = (G % 8 == 0) ? (bx % 8) * (G / 8) + bx / 8 : bx;
    unsigned char* ws = args.ws;
    volatile LAS unsigned* MISC = (volatile LAS unsigned*)(lds + LDSCTL_OFF);
    LAS int* tb = (LAS int*)(lds + LDSCTL_OFF + 64); LAS int* cn = (LAS int*)(lds + LDSCTL_OFF + 256);
    { FRESH_IDS(); (void)lane; (void)wave; for (int u = tid; u < 128; u += NWAVES * 64) ((LAS unsigned*)(lds + LDSCTL_OFF))[u] = 0u; }
    __syncthreads();
#if ONE_LAUNCH
    XcdBarrier bar = xcd_barrier_post((unsigned*)(ws + WS_CTL) + CW_BAR, MISC);
#define GRID_BAR() xcd_barrier(bar)
#else
#define GRID_BAR() do {} while (0)
#endif
    const int lo = args.ph_lo, hi = args.ph_hi;
#define IN(k) (lo <= (k) && (k) < hi)
#define BOTH(k) (IN(k) && IN((k) + 1))
    if (IN(0)) { FRESH_IDS(); p0_prep(args, lds, tid, lane, wave, vcu, G); moe_conv_lds(args, lds, lane, wave, vcu * NWAVES + wave, G * NWAVES); if (BOTH(0)) GRID_BAR(); }
    if (IN(1)) {
        {
        { pg8::Gemm g{(const pg8::bf16_t*)(ws + WS_XB), (const pg8::bf16_t*)(ws + WS_WINT), NTOK, DPJ, DM}; pg8::StaticOrder S; S.init(NTOK, DPJ, G, bx);
          pg8::EpiZ E{(pg8::bf16_t*)(ws + WS_Z), DPJ, 6};
          pg8::gemm_phase<pg8::EpiZ, pg8::StaticOrder, true, BF16_SP2>(lds, g, S, E); }
        { pg8::Gemm g{(const pg8::bf16_t*)(ws + WS_MEMB), (const pg8::bf16_t*)(ws + WS_WMKVT), 2048, 1024, DM}; pg8::StaticOrder S; S.init(2048, 1024, G, (bx + G - MKV_SHIFT) % G);
          pg8::EpiZ E{(pg8::bf16_t*)(ws + WS_MKV), 1024, 0};
          pg8::gemm_phase<pg8::EpiZ, pg8::StaticOrder, true, BF16_SP2>(lds, g, S, E); }
        }
        if (BOTH(1)) GRID_BAR();
    }
    if (IN(2)) { FRESH_IDS();
        for (int u = vcu; u < NTOK / 128; u += G) sgu_unit_mfma(args, lds, u, tid, lane, wave);
        p2_attn_chain(args, lds, tid, lane, wave, vcu, G);
        if (BOTH(2)) GRID_BAR(); }
    if (IN(3)) { FRESH_IDS(); (void)tid;
        p2b_combine(args, lane, wave, vcu, G);
        if (BOTH(3)) GRID_BAR(); }
    if (IN(4)) {
        pg8::Gemm g{(const pg8::bf16_t*)(ws + WS_Y), (const pg8::bf16_t*)(ws + WS_WOUTT), NTOK, DM, DM}; pg8::StaticOrder S; S.init(NTOK, DM, G, bx);
        pg8::EpiRes E{(const pg8::bf16_t*)(ws + WS_XB), (pg8::bf16_t*)(ws + WS_H1), DM, DN_ALPHA};
        pg8::gemm_phase<pg8::EpiRes, pg8::StaticOrder, true, BF16_SP2>(lds, g, S, E);
        if (BOTH(4)) GRID_BAR();
    }
    if (IN(5)) { FRESH_IDS(); p5_ln1_router_wave(args, lds, tid, lane, wave, vcu, G, 0); if (BOTH(5)) GRID_BAR(); }
    if (IN(6)) { FRESH_IDS(); (void)lane; (void)wave; moe_table(args, tb, cn, tid); p6_tables(args, tb, cn, tid, vcu, G); if (BOTH(6)) GRID_BAR(); }
    if (IN(7)) {
        { FRESH_IDS(); (void)lane; (void)wave; moe_table(args, tb, cn, tid); }
        pg8::Gemm g{(const pg8::bf16_t*)(ws + WS_X1Q), (const pg8::bf16_t*)(ws + WS_WGUT), NTOK, NEXP * 4096, DM / 2};
        pg8::MoeOrder S{(const PG8_LAS int*)tb, 4, G, bx, tb[32] * 16, 0, lds + UTAB_OFF, (const char*)(ws + WS_ROWOFF), args.in[I_BGU]};
        pg8::EpiGU E{ws + WS_ACT, args.in[I_BGU], 1.0f / (W_SCALE * XS_SCALE), ACT_SCALE};
        pg8::gemm_phase_ut<pg8::EpiGU, pg8::MoeOrder, true>(lds, g, S, E);
        if (BOTH(7)) GRID_BAR();
    }
    if (IN(8)) {
        { FRESH_IDS(); (void)lane; (void)wave; moe_table(args, tb, cn, tid); }
        pg8::Gemm g{(const pg8::bf16_t*)(ws + WS_ACT), (const pg8::bf16_t*)(ws + WS_WDT), MAXROWS, NEXP * 2048, DM / 2};
        pg8::MoeOrder S{(const PG8_LAS int*)tb, 3, G, bx, tb[32] * 8, 0, lds + UTAB_OFF, (const char*)(ws + WS_ROWGATE), args.in[I_BD]};
        pg8::EpiDown E{ws + WS_YS, args.in[I_BD], (const float*)(ws + WS_ROWGATE), 1.0f / (W_SCALE * ACT_SCALE), YS_SCALE};
        pg8::gemm_phase_ut<pg8::EpiDown, pg8::MoeOrder, false>(lds, g, S, E);
        if (BOTH(8)) GRID_BAR();
    }
    if (IN(9)) { FRESH_IDS(); p8_final(args, lds, tid, lane, wave, vcu, G); }
#undef IN
#undef BOTH
}

extern "C" void kernel_launch(void* const* d_in, const int* in_sizes, int n_in, void* d_out, int out_size, void* d_ws, size_t ws_size, hipStream_t stream) {
    static int grid = 0;
    if (grid == 0) {
        if (n_in != 22 || in_sizes[0] != NTOK * DM || out_size != NTOK * DM || ws_size < WS_END) { fprintf(stderr, "kernel_launch: unexpected shapes (n_in %d, in0 %d, out %d, ws %zu < %zu)\n", n_in, n_in > 0 ? in_sizes[0] : -1, out_size, ws_size, (size_t)WS_END); grid = -1; return; }
        int dev = 0, cus = 0, per_cu = 0;
        if (hipGetDevice(&dev) != hipSuccess || hipDeviceGetAttribute(&cus, hipDeviceAttributeMultiprocessorCount, dev) != hipSuccess) { grid = -1; return; }
        if (hipFuncSetAttribute((const void*)fwd_kernel, hipFuncAttributeMaxDynamicSharedMemorySize, LDS_BYTES) != hipSuccess) { fprintf(stderr, "kernel_launch: hipFuncSetAttribute failed\n"); grid = -1; return; }
        if (hipOccupancyMaxActiveBlocksPerMultiprocessor(&per_cu, (const void*)fwd_kernel, NWAVES * 64, LDS_BYTES) != hipSuccess || per_cu < 1) fprintf(stderr, "kernel_launch: occupancy query reports %d\n", per_cu);
        (void)hipGetLastError();
        grid = cus;
    }
    if (grid < 0) return;
    if (hipMemsetAsync((char*)d_ws + WS_CTL, 0, CTL_ZERO_BYTES, stream) != hipSuccess) return;
    Args a{};
    for (int i = 0; i < 22; ++i) a.in[i] = (const float*)d_in[i];
    a.out = (float*)d_out; a.ws = (unsigned char*)d_ws;
#if ONE_LAUNCH
    a.ph_lo = 0; a.ph_hi = NPHASE;
    hipLaunchKernelGGL(fwd_kernel, dim3(grid), dim3(NWAVES * 64), LDS_BYTES, stream, a);
#else
    for (int p = 0; p < NPHASE; ++p) { a.ph_lo = p; a.ph_hi = p + 1; hipLaunchKernelGGL(fwd_kernel, dim3(grid), dim3(NWAVES * 64), LDS_BYTES, stream, a); }
#endif
}
```

```cpp
#include <hip/hip_runtime.h>
#include <cstdio>
#include <cstdint>
#ifndef ONE_LAUNCH
#define ONE_LAUNCH 1
#endif
#ifndef MOE_RT8
#define MOE_RT8 4
#endif
#ifndef BF16_SP2
#define BF16_SP2 true
#endif
namespace pg8 {
#define PG8_LAS __attribute__((address_space(3)))
typedef unsigned short bf16_t;
typedef short bf16x8 __attribute__((ext_vector_type(8)));
typedef float f32x4 __attribute__((ext_vector_type(4)));
typedef unsigned u32x4 __attribute__((ext_vector_type(4)));
typedef int i32x4 __attribute__((ext_vector_type(4)));
typedef unsigned u32x2 __attribute__((ext_vector_type(2)));
constexpr int BM = 256, BK = 64, HALF = 128, HTB = HALF * BK * 2  , STAGE_BYTES = 8 * HTB, NXCD = 8, WGM = 8;

__host__ __device__ __forceinline__ int lds_byte(int r, int c) { const int st = (r >> 4) * 2 + (c >> 5), rr = r & 15, cc = c & 31, ob = rr * 64 + cc * 2; return st * 1024 + (ob ^ (((ob >> 9) & 1) << 5)); }
__host__ __device__ __forceinline__ void stage_rc(int b, int& R, int& C) { const int st = b / 1024, sb = b % 1024, swz = sb ^ (((sb >> 9) & 1) << 5); R = (st >> 1) * 16 + swz / 64; C = (st & 1) * 32 + (swz % 64) / 2; }
__host__ __device__ __forceinline__ int perm32(int rho) { const int n = rho >> 4, i = rho & 15; return 8 * (i >> 2) + 4 * n + (i & 3); }

struct Unit { int pm, pn; };
struct Gemm { const bf16_t* A; const bf16_t* Bt; int M, N, K; };

struct StaticOrder {
    int nM, nN, nwg, G, c;
    __host__ __device__ void init(int M, int N, int G_, int c_) { nM = M / BM; nN = N / BM; nwg = nM * nN; G = G_; c = c_; }
    __host__ __device__ bool next(int i, Unit& u) const {
        const long L = (long)i * G + c; if (L >= nwg) return false;
        int wgid = (int)L; { const int q = nwg / NXCD, r = nwg % NXCD, xcd = wgid % NXCD, off = wgid / NXCD; wgid = (xcd < r ? xcd * (q + 1) : r * (q + 1) + (xcd - r) * q) + off; }
        const int nig = WGM * nN, gid = wgid / nig, fm = gid * WGM, gsz = (nM - fm) < WGM ? (nM - fm) : WGM;
        u.pm = fm + ((wgid % nig) % gsz); u.pn = (wgid % nig) / gsz; return true;
    }
    __device__ __forceinline__ void a_ready(const Unit&) const {}
    __device__ __forceinline__ void done(const Unit&) const {}
};
__device__ __forceinline__ unsigned cvt_pk_bf16(float lo, float hi) { unsigned r; asm volatile("v_cvt_pk_bf16_f32 %0, %1, %2" : "=v"(r) : "v"(lo), "v"(hi)); return r; }
typedef float f32x2 __attribute__((ext_vector_type(2)));
__device__ __forceinline__ float gelu_tanh(float x) {
    const float u = x * (1.0f + 0.044715f * x * x);
    const float e = __builtin_amdgcn_exp2f(u * -2.302208198f);
    return x * __builtin_amdgcn_rcpf(1.0f + e);
}
__device__ __forceinline__ float swiglu_act(float gate, float up) {
    const float g = fminf(gate, 7.0f), u = fminf(fmaxf(up, -7.0f), 7.0f);
    const float e = __builtin_amdgcn_exp2f(g * -2.455466959f);
    return (u + 1.0f) * g * __builtin_amdgcn_rcpf(1.0f + e);
}
__device__ __forceinline__ f32x2 gelu_tanh_pk(f32x2 x) {
    const f32x2 t = (x * x) * (-2.302208198f * 0.044715f) + (-2.302208198f), z = x * t;
    f32x2 ex; ex.x = __builtin_amdgcn_exp2f(z.x); ex.y = __builtin_amdgcn_exp2f(z.y);
    const f32x2 d = ex + 1.0f; f32x2 r; r.x = __builtin_amdgcn_rcpf(d.x); r.y = __builtin_amdgcn_rcpf(d.y);
    return x * r;
}
__device__ __forceinline__ f32x2 swiglu_pk(f32x2 gate, f32x2 up, float oscale) {
    const f32x2 g = __builtin_elementwise_min(gate, (f32x2){7.0f, 7.0f}), u = __builtin_elementwise_min(__builtin_elementwise_max(up, (f32x2){-7.0f, -7.0f}), (f32x2){7.0f, 7.0f});
    const f32x2 z = g * -2.455466959f; f32x2 ex; ex.x = __builtin_amdgcn_exp2f(z.x); ex.y = __builtin_amdgcn_exp2f(z.y);
    const f32x2 d = ex + 1.0f; f32x2 r; r.x = __builtin_amdgcn_rcpf(d.x); r.y = __builtin_amdgcn_rcpf(d.y);
    return (u * oscale + oscale) * (g * r);
}
struct EpiZ {
    static constexpr bool PERM = true, AFTER_DRAIN = false;
    bf16_t* O; int ldc; int nact;
    __device__ __forceinline__ void operator()(const f32x4 (&acc)[2][2][4][2], const Unit& u, int wr, int wc, int fr, int fq) const {
        const int row0 = u.pm * BM + wr * 64 + fr, col0 = u.pn * BM + wc * 32 + 8 * fq; const bool act = u.pn < nact;
#pragma unroll
        for (int ai = 0; ai < 2; ++ai)
#pragma unroll
            for (int m = 0; m < 4; ++m) { bf16_t* rowp = O + (size_t)(row0 + ai * HALF + m * 16) * ldc + col0;
#pragma unroll
                for (int bj = 0; bj < 2; ++bj) { f32x4 v0 = acc[ai][bj][m][0], v1 = acc[ai][bj][m][1];
                    if (act) {
#pragma unroll
                        for (int j = 0; j < 1; ++j) { const f32x2 a0 = gelu_tanh_pk((f32x2){v0[0], v0[1]}), a1 = gelu_tanh_pk((f32x2){v0[2], v0[3]}), b0 = gelu_tanh_pk((f32x2){v1[0], v1[1]}), b1 = gelu_tanh_pk((f32x2){v1[2], v1[3]});
                            v0 = (f32x4){a0.x, a0.y, a1.x, a1.y}; v1 = (f32x4){b0.x, b0.y, b1.x, b1.y}; } }
                    u32x4 w; w.x = cvt_pk_bf16(v0[0], v0[1]); w.y = cvt_pk_bf16(v0[2], v0[3]); w.z = cvt_pk_bf16(v1[0], v1[1]); w.w = cvt_pk_bf16(v1[2], v1[3]);
                    *(u32x4*)(rowp + bj * HALF) = w; } }
    }
};
struct EpiRes {
    static constexpr bool PERM = true, AFTER_DRAIN = false;
    const bf16_t* X; bf16_t* H; int ldc; float alpha;
    __device__ __forceinline__ void operator()(const f32x4 (&acc)[2][2][4][2], const Unit& u, int wr, int wc, int fr, int fq) const {
        const int row0 = u.pm * BM + wr * 64 + fr, col0 = u.pn * BM + wc * 32 + 8 * fq;
        u32x4 xr[2][4][2];
#pragma unroll
        for (int ai = 0; ai < 2; ++ai)
#pragma unroll
            for (int m = 0; m < 4; ++m)
#pragma unroll
                for (int bj = 0; bj < 2; ++bj) xr[ai][m][bj] = *(const u32x4*)(X + (size_t)(row0 + ai * HALF + m * 16) * ldc + col0 + bj * HALF);
        asm volatile("" ::: "memory");
#pragma unroll
        for (int ai = 0; ai < 2; ++ai)
#pragma unroll
            for (int m = 0; m < 4; ++m) { const size_t off = (size_t)(row0 + ai * HALF + m * 16) * ldc + col0;
#pragma unroll
                for (int bj = 0; bj < 2; ++bj) { const u32x4 xw = xr[ai][m][bj]; const f32x4 a0 = acc[ai][bj][m][0], a1 = acc[ai][bj][m][1];
                    u32x4 w; w.x = cvt_pk_bf16(__uint_as_float(xw.x << 16) * alpha + a0[0], __uint_as_float(xw.x & 0xffff0000u) * alpha + a0[1]); w.y = cvt_pk_bf16(__uint_as_float(xw.y << 16) * alpha + a0[2], __uint_as_float(xw.y & 0xffff0000u) * alpha + a0[3]);
                    w.z = cvt_pk_bf16(__uint_as_float(xw.z << 16) * alpha + a1[0], __uint_as_float(xw.z & 0xffff0000u) * alpha + a1[1]); w.w = cvt_pk_bf16(__uint_as_float(xw.w << 16) * alpha + a1[2], __uint_as_float(xw.w & 0xffff0000u) * alpha + a1[3]);
                    *(u32x4*)(H + off + bj * HALF) = w; } }
    }
};
__device__ __forceinline__ unsigned pk4_fp8e(float a, float b, float c, float d) { int r = __builtin_amdgcn_cvt_pk_fp8_f32(a, b, 0, false); r = __builtin_amdgcn_cvt_pk_fp8_f32(c, d, r, true); return (unsigned)r; }
struct EpiGU {
    static constexpr bool PERM = true, AFTER_DRAIN = false;
    unsigned char* ACT; const float* bgu; float ascale, oscale;
    __device__ __forceinline__ void operator()(const f32x4 (&acc)[2][2][4][2], const Unit& u, int wr, int wc, int fr, int fq, const PG8_LAS unsigned char* ut) const {
        const int pnl = u.pn & 15; const int row0 = u.pm * BM + wr * 64 + fr, cl = pnl * 128 + wc * 32 + 8 * fq;
        const PG8_LAS float* bg = (const PG8_LAS float*)(ut + 1024) + wc * 32 + 8 * fq; const PG8_LAS float* bu = bg + 128;
        const f32x4 g0 = *(const PG8_LAS f32x4*)bg, g1 = *(const PG8_LAS f32x4*)(bg + 4), u0 = *(const PG8_LAS f32x4*)bu, u1 = *(const PG8_LAS f32x4*)(bu + 4);
#pragma unroll
        for (int ai = 0; ai < 2; ++ai)
#pragma unroll
            for (int m = 0; m < 4; ++m) { unsigned char* rowp = ACT + (size_t)(row0 + ai * HALF + m * 16) * 2048 + cl;
                const f32x4 ga = acc[ai][0][m][0] * ascale + g0, gb = acc[ai][0][m][1] * ascale + g1, ua = acc[ai][1][m][0] * ascale + u0, ub = acc[ai][1][m][1] * ascale + u1;
                f32x4 ra, rb;
#pragma unroll
                for (int j = 0; j < 1; ++j) { const f32x2 a0 = swiglu_pk((f32x2){ga[0], ga[1]}, (f32x2){ua[0], ua[1]}, oscale), a1 = swiglu_pk((f32x2){ga[2], ga[3]}, (f32x2){ua[2], ua[3]}, oscale), b0 = swiglu_pk((f32x2){gb[0], gb[1]}, (f32x2){ub[0], ub[1]}, oscale), b1 = swiglu_pk((f32x2){gb[2], gb[3]}, (f32x2){ub[2], ub[3]}, oscale);
                    ra = (f32x4){a0.x, a0.y, a1.x, a1.y}; rb = (f32x4){b0.x, b0.y, b1.x, b1.y}; }
                u32x2 w; w.x = pk4_fp8e(ra[0], ra[1], ra[2], ra[3]); w.y = pk4_fp8e(rb[0], rb[1], rb[2], rb[3]);
                *(u32x2*)rowp = w; }
    }
};
struct EpiDown {
    static constexpr bool PERM = true, AFTER_DRAIN = false;
    unsigned char* YS; const float* bd; const float* rowgate; float ascale, oscale;
    __device__ __forceinline__ void operator()(const f32x4 (&acc)[2][2][4][2], const Unit& u, int wr, int wc, int fr, int fq, const PG8_LAS unsigned char* ut) const {
        const int pnl = u.pn & 7; const int row0 = u.pm * BM + wr * 64 + fr, col0 = pnl * BM + wc * 32 + 8 * fq;
        f32x4 bv[2][2]; const PG8_LAS float* bl = (const PG8_LAS float*)(ut + 1024) + wc * 32 + 8 * fq; const PG8_LAS float* gl = (const PG8_LAS float*)ut + wr * 64 + fr;
#pragma unroll
        for (int bj = 0; bj < 2; ++bj)
#pragma unroll
            for (int n = 0; n < 2; ++n) bv[bj][n] = *(const PG8_LAS f32x4*)(bl + bj * HALF + 4 * n);
#pragma unroll
        for (int ai = 0; ai < 2; ++ai)
#pragma unroll
            for (int m = 0; m < 4; ++m) { const int r = row0 + ai * HALF + m * 16; const float gt = gl[ai * HALF + m * 16] * oscale; unsigned char* rowp = YS + (size_t)r * 2048 + col0;
                u32x2 w[2];
#pragma unroll
                for (int bj = 0; bj < 2; ++bj) { const f32x4 v0 = (acc[ai][bj][m][0] * ascale + bv[bj][0]) * gt, v1 = (acc[ai][bj][m][1] * ascale + bv[bj][1]) * gt;
                    w[bj].x = pk4_fp8e(v0[0], v0[1], v0[2], v0[3]); w[bj].y = pk4_fp8e(v1[0], v1[1], v1[2], v1[3]); }
                typedef unsigned ed_u2 __attribute__((ext_vector_type(2)));
                const ed_u2 sx = __builtin_amdgcn_permlane16_swap(w[0].x, w[1].x, false, false), sy = __builtin_amdgcn_permlane16_swap(w[0].y, w[1].y, false, false);
                u32x4 q; q.x = sx.x; q.y = sy.x; q.z = sx.y; q.w = sy.y;
                *(u32x4*)(rowp + ((fq & 1) ? HALF - 8 : 0)) = q; }
    }
};
struct MoeOrder {
    const PG8_LAS int* tb; int sh, G, c, total, hot; PG8_LAS unsigned char* utab; const char* tabA; const float* bias;
    __device__ __forceinline__ void srcs(const Unit& u, int lane, const char*& sa, const char*& sb) const {
        sa = tabA + ((size_t)u.pm * 256 + lane * 4) * 4;
        if (sh == 4) { const float* b0 = bias + (size_t)(u.pn >> 4) * 4096 + (u.pn & 15) * 128; sb = (const char*)(lane < 32 ? b0 + lane * 4 : b0 + 2048 + (lane - 32) * 4); }
        else sb = (const char*)(bias + (size_t)(u.pn >> 3) * 2048 + (u.pn & 7) * 256 + lane * 4);
    }
    __device__ __forceinline__ bool next(int i, Unit& u) const {
        const long L = (long)i * G + c; if (!(sh == 3 && G == 256) && L >= total) return false;
        if (hot) { u.pm = (int)(L & 7); u.pn = (int)((L >> 3) & 3); return true; }
        int mtg = (int)(L >> sh), pn = (int)L & ((1 << sh) - 1);
        if (sh == 3 && G == 256) {
            const int RT = MOE_RT8, CT = 32 / RT, NCG = (1 << sh) / CT;
            const int s = i * 8 + (c & 7), j = c >> 3; const int rg = s / NCG, cg = s % NCG;
            mtg = rg * RT + (j % RT); pn = cg * CT + j / RT; if (mtg >= tb[32]) return false; }
        int e = 0;
#pragma unroll
        for (int j = 1; j < 32; ++j) e += (tb[j] <= mtg) ? 1 : 0;
        u.pm = mtg; u.pn = (e << sh) + pn; return true;
    }
    __device__ __forceinline__ void a_ready(const Unit&) const {}
    __device__ __forceinline__ void done(const Unit&) const {}
};
template <class Epi, class Sched, bool ALIGN_EPI = false, bool SP2 = false, bool FP8 = false, int PROBE = 0>
__device__ __forceinline__ void gemm_phase(PG8_LAS unsigned char* lds, const Gemm g, const Sched& S, const Epi& E) {
    const int tid = threadIdx.x, wid = __builtin_amdgcn_readfirstlane(tid >> 6), lane = tid & 63, wr = wid >> 2, wc = wid & 3, fr = lane & 15, fq = lane >> 4;
    const int K = g.K, nt = K / BK;
    unsigned voffA[2], voffB[2];
#pragma unroll
    for (int i = 0; i < 2; ++i) { int R, C; stage_rc(tid * 16 + i * 8192, R, C); const int Rb = Epi::PERM ? ((R & ~31) + perm32(R & 31)) : R;
        voffA[i] = (unsigned)(R * K + C) * 2u; voffB[i] = (unsigned)(Rb * K + C) * 2u; }
    const size_t kstep = (size_t)(BK * 2);
    const size_t hstep = (size_t)HALF * K * 2;
    const size_t tstep = 2 * hstep;
    const unsigned ldsw = (unsigned)wid * 1024u;
    const int aoff = lds_byte(wr * 64 + fr, fq * 8), boff = lds_byte(wc * 32 + fr, fq * 8);
#define PG8_SA(b, h) (((b) * 2 + (h)) * HTB)
#define PG8_SB(b, h) ((4 + (b) * 2 + (h)) * HTB)
#define PG8_STAGE(bufoff, gbase, voff) do { if (PROBE != 2) _Pragma("unroll") for (int _i = 0; _i < 2; ++_i) \
        __builtin_amdgcn_global_load_lds((const unsigned*)((const char*)(gbase) + (voff)[_i]), (PG8_LAS unsigned*)(lds + (bufoff) + ldsw + _i * 8192), 16, 0, 0); } while (0)
#define PG8_LDA(dst, b, h) do { _Pragma("unroll") for (int m = 0; m < 4; ++m) _Pragma("unroll") for (int k = 0; k < 2; ++k) dst[m][k] = *(const PG8_LAS bf16x8*)(lds + PG8_SA(b, h) + aoff + m * 2048 + k * 1024); } while (0)
#define PG8_LDB(dst, b, h) do { _Pragma("unroll") for (int n = 0; n < 2; ++n) _Pragma("unroll") for (int k = 0; k < 2; ++k) dst[n][k] = *(const PG8_LAS bf16x8*)(lds + PG8_SB(b, h) + boff + n * 2048 + k * 1024); } while (0)
#define PG8_CAT(x) __builtin_shufflevector(__builtin_bit_cast(i32x4, (x)[0]), __builtin_bit_cast(i32x4, (x)[1]), 0, 1, 2, 3, 4, 5, 6, 7)
#define PG8_MMA(ai, bj, At, Bt) do { __builtin_amdgcn_s_setprio(1); if constexpr (PROBE == 1) { asm volatile("" :: "v"(At[0][0]), "v"(At[3][1]), "v"(Bt[0][0]), "v"(Bt[1][1])); } else if constexpr (FP8) { _Pragma("unroll") for (int m = 0; m < 4; ++m) _Pragma("unroll") for (int n = 0; n < 2; ++n) \
        asm volatile("v_mfma_f32_16x16x128_f8f6f4 %0, %1, %2, %0" : "+v"(acc[ai][bj][m][n]) : "v"(PG8_CAT(Bt[n])), "v"(PG8_CAT(At[m]))); } else { \
        _Pragma("unroll") for (int m = 0; m < 4; ++m) _Pragma("unroll") for (int n = 0; n < 2; ++n) _Pragma("unroll") for (int k = 0; k < 2; ++k) \
        acc[ai][bj][m][n] = __builtin_amdgcn_mfma_f32_16x16x32_bf16(Bt[n][k], At[m][k], acc[ai][bj][m][n], 0, 0, 0); } __builtin_amdgcn_s_setprio(0); } while (0)
#define PG8_WAIT_V(n) asm volatile("s_waitcnt vmcnt(" #n ")" ::: "memory")
#define PG8_WAIT_L(n) asm volatile("s_waitcnt lgkmcnt(" #n ")" ::: "memory")
#define PG8_BAR __builtin_amdgcn_s_barrier()
#define PG8_SCHED __builtin_amdgcn_sched_barrier(0)
    Unit cur, nxt; int ui = 0;
    if (!S.next(0, cur)) return;
    f32x4 acc[2][2][4][2];
#pragma unroll
    for (int a = 0; a < 2; ++a)
#pragma unroll
        for (int b = 0; b < 2; ++b)
#pragma unroll
            for (int m = 0; m < 4; ++m)
#pragma unroll
                for (int n = 0; n < 2; ++n) acc[a][b][m][n] = (f32x4){0.f, 0.f, 0.f, 0.f};
    bf16x8 At[4][2], B0[2][2], B1[2][2];
    const char* cA = (const char*)g.A + (size_t)cur.pm * tstep; const char* cB = (const char*)g.Bt + (size_t)cur.pn * tstep;
    S.a_ready(cur);
    if constexpr (SP2) {
        PG8_STAGE(PG8_SB(0, 0), cB, voffB); PG8_STAGE(PG8_SB(0, 1), cB + hstep, voffB); PG8_STAGE(PG8_SA(0, 0), cA, voffA); PG8_STAGE(PG8_SA(0, 1), cA + hstep, voffA);
        if (wr == 1) PG8_BAR;
        PG8_WAIT_V(2); PG8_BAR;
        PG8_STAGE(PG8_SB(1, 0), cB + kstep, voffB); PG8_STAGE(PG8_SA(1, 0), cA + kstep, voffA); PG8_STAGE(PG8_SB(1, 1), cB + hstep + kstep, voffB);
        PG8_WAIT_V(6); PG8_BAR;
    } else {
        PG8_STAGE(PG8_SB(0, 0), cB, voffB); PG8_STAGE(PG8_SA(0, 0), cA, voffA); PG8_STAGE(PG8_SB(0, 1), cB + hstep, voffB); PG8_STAGE(PG8_SA(0, 1), cA + hstep, voffA);
        if (wr == 1) PG8_BAR;
        PG8_WAIT_V(4); PG8_BAR;
        PG8_STAGE(PG8_SB(1, 0), cB + kstep, voffB); PG8_STAGE(PG8_SA(1, 0), cA + kstep, voffA); PG8_STAGE(PG8_SB(1, 1), cB + hstep + kstep, voffB);
        PG8_WAIT_V(6); PG8_BAR;
    }
    for (;;) {
        const bool has_next = S.next(ui + 1, nxt);
        const char* nA = has_next ? (const char*)g.A + (size_t)nxt.pm * tstep : cA; const char* nB = has_next ? (const char*)g.Bt + (size_t)nxt.pn * tstep : cB;
        for (int t = 0; t < nt; t += 2) {
            const bool last = (t == nt - 2);
            const char* a1 = cA + (size_t)(t + 1) * kstep;
            const char* a2 = last ? nA : cA + (size_t)(t + 2) * kstep; const char* b2 = last ? nB : cB + (size_t)(t + 2) * kstep;
            const char* a3 = a2 + kstep; const char* b3 = b2 + kstep;
            if (last && has_next) S.a_ready(nxt);
            if constexpr (SP2) {
            PG8_LDB(B0, 0, 0); PG8_LDB(B1, 0, 1); PG8_SCHED; PG8_LDA(At, 0, 0); PG8_STAGE(PG8_SA(1, 1), a1 + hstep, voffA);
            PG8_WAIT_V(8); PG8_WAIT_L(0); PG8_BAR; PG8_MMA(0, 0, At, B0); PG8_MMA(0, 1, At, B1); PG8_BAR; PG8_SCHED;
            PG8_LDA(At, 0, 1); PG8_STAGE(PG8_SB(0, 0), b2, voffB); PG8_STAGE(PG8_SB(0, 1), b2 + hstep, voffB); PG8_STAGE(PG8_SA(0, 0), a2, voffA);
            PG8_WAIT_V(8); PG8_WAIT_L(0); PG8_BAR; PG8_MMA(1, 0, At, B0); PG8_MMA(1, 1, At, B1); PG8_BAR; PG8_SCHED;
            PG8_LDB(B0, 1, 0); PG8_LDB(B1, 1, 1); PG8_SCHED; PG8_LDA(At, 1, 0); PG8_STAGE(PG8_SA(0, 1), a2 + hstep, voffA);
            PG8_WAIT_V(8); PG8_WAIT_L(0); PG8_BAR; PG8_MMA(0, 0, At, B0); PG8_MMA(0, 1, At, B1); PG8_BAR; PG8_SCHED;
            PG8_LDA(At, 1, 1); PG8_STAGE(PG8_SB(1, 0), b3, voffB); PG8_STAGE(PG8_SB(1, 1), b3 + hstep, voffB); PG8_STAGE(PG8_SA(1, 0), a3, voffA);
            PG8_WAIT_V(8); PG8_WAIT_L(0); PG8_BAR; PG8_MMA(1, 0, At, B0); PG8_MMA(1, 1, At, B1); PG8_BAR; PG8_SCHED;
            } else {
            PG8_LDB(B0, 0, 0); PG8_SCHED; PG8_LDA(At, 0, 0); PG8_STAGE(PG8_SA(1, 1), a1 + hstep, voffA);
            PG8_WAIT_L(8); PG8_BAR; PG8_WAIT_L(0); PG8_MMA(0, 0, At, B0); PG8_BAR; PG8_SCHED;
            PG8_LDB(B1, 0, 1); PG8_STAGE(PG8_SB(0, 0), b2, voffB);
            PG8_BAR; PG8_WAIT_L(0); PG8_MMA(0, 1, At, B1); PG8_BAR;
            PG8_LDA(At, 0, 1); PG8_STAGE(PG8_SA(0, 0), a2, voffA);
            PG8_BAR; PG8_WAIT_L(0); PG8_MMA(1, 0, At, B0); PG8_BAR; PG8_SCHED;
            PG8_STAGE(PG8_SB(0, 1), b2 + hstep, voffB);
            PG8_WAIT_V(6); PG8_BAR; PG8_MMA(1, 1, At, B1); PG8_BAR;
            PG8_LDB(B0, 1, 0); PG8_SCHED; PG8_LDA(At, 1, 0); PG8_STAGE(PG8_SA(0, 1), a2 + hstep, voffA);
            PG8_WAIT_L(8); PG8_BAR; PG8_WAIT_L(0); PG8_MMA(0, 0, At, B0); PG8_BAR; PG8_SCHED;
            PG8_LDB(B1, 1, 1); PG8_STAGE(PG8_SB(1, 0), b3, voffB);
            PG8_BAR; PG8_WAIT_L(0); PG8_MMA(0, 1, At, B1); PG8_BAR;
            PG8_LDA(At, 1, 1); PG8_STAGE(PG8_SA(1, 0), a3, voffA);
            PG8_BAR; PG8_WAIT_L(0); PG8_MMA(1, 0, At, B0); PG8_BAR; PG8_SCHED;
            PG8_STAGE(PG8_SB(1, 1), b3 + hstep, voffB);
            PG8_WAIT_V(6); PG8_BAR; PG8_MMA(1, 1, At, B1); PG8_BAR;
            }
        }
        if constexpr (ALIGN_EPI) { if (wr == 0) PG8_BAR; }
        if constexpr (FP8) asm volatile("s_nop 15\n\ts_nop 15" ::: "memory");
        if constexpr (!Epi::AFTER_DRAIN) { E(acc, cur, wr, wc, fr, fq); S.done(cur); }
        if (!has_next) break;
#pragma unroll
        for (int a = 0; a < 2; ++a)
#pragma unroll
            for (int b = 0; b < 2; ++b)
#pragma unroll
                for (int m = 0; m < 4; ++m)
#pragma unroll
                    for (int n = 0; n < 2; ++n) acc[a][b][m][n] = (f32x4){0.f, 0.f, 0.f, 0.f};
        cur = nxt; cA = nA; cB = nB; ++ui;
        if constexpr (ALIGN_EPI) { if (wr == 1) PG8_BAR; }
    }
    PG8_WAIT_V(0);
    if constexpr (!ALIGN_EPI) { if (wr == 0) PG8_BAR; }
    PG8_BAR;
    if constexpr (Epi::AFTER_DRAIN) { E.fused(acc, cur, wr, wc, fr, fq, lds, wid, lane); S.done(cur); }
#undef PG8_SA
#undef PG8_SB
#undef PG8_STAGE
#undef PG8_LDA
#undef PG8_LDB
#undef PG8_MMA
#undef PG8_CAT
#undef PG8_WAIT_V
#undef PG8_WAIT_L
#undef PG8_BAR
#undef PG8_SCHED
}
}
namespace pg8 {
template <class Epi, class Sched, bool GATHER, int PROBE = 0>
__device__ __forceinline__ void gemm_phase_ut(PG8_LAS unsigned char* lds, const Gemm g, const Sched& S, const Epi& E) {
    const int tid = threadIdx.x, wid = __builtin_amdgcn_readfirstlane(tid >> 6), lane = tid & 63, wr = wid >> 2, wc = wid & 3, fr = lane & 15, fq = lane >> 4;
    const int K = g.K, nt = K / BK;
    unsigned voffA[2], voffB[2]; int R0, C0; stage_rc(tid * 16, R0, C0);
#pragma unroll
    for (int i = 0; i < 2; ++i) { int R, C; stage_rc(tid * 16 + i * 8192, R, C); const int Rb = Epi::PERM ? ((R & ~31) + perm32(R & 31)) : R;
        voffA[i] = (unsigned)(R * K + C) * 2u; voffB[i] = (unsigned)(Rb * K + C) * 2u; }
    const size_t kstep = (size_t)(BK * 2), hstep = (size_t)HALF * K * 2, tstep = 2 * hstep;
    const unsigned ldsw = (unsigned)wid * 1024u;
    const int aoff = lds_byte(wr * 64 + fr, fq * 8), boff = lds_byte(wc * 32 + fr, fq * 8);
    PG8_LAS unsigned char* utab = S.utab;
#define PG8_SA(b, h) (((b) * 2 + (h)) * HTB)
#define PG8_SB(b, h) ((4 + (b) * 2 + (h)) * HTB)
#define PG8_STAGE(bufoff, gbase, voff) do { if (PROBE != 2) _Pragma("unroll") for (int _i = 0; _i < 2; ++_i) \
        __builtin_amdgcn_global_load_lds((const unsigned*)((const char*)(gbase) + (voff)[_i]), (PG8_LAS unsigned*)(lds + (bufoff) + ldsw + _i * 8192), 16, 0, 0); } while (0)
#define PG8_STAGE_A(b, h, dense_ptr, kt_ptr, off) do { if constexpr (GATHER) { PG8_STAGE(PG8_SA(b, h), kt_ptr, (off)[h]); } else { PG8_STAGE(PG8_SA(b, h), (dense_ptr) + (h) * hstep, voffA); } } while (0)
#define PG8_LDA(dst, b, h) do { _Pragma("unroll") for (int m = 0; m < 4; ++m) _Pragma("unroll") for (int k = 0; k < 2; ++k) dst[m][k] = *(const PG8_LAS bf16x8*)(lds + PG8_SA(b, h) + aoff + m * 2048 + k * 1024); } while (0)
#define PG8_LDB(dst, b, h) do { _Pragma("unroll") for (int n = 0; n < 2; ++n) _Pragma("unroll") for (int k = 0; k < 2; ++k) dst[n][k] = *(const PG8_LAS bf16x8*)(lds + PG8_SB(b, h) + boff + n * 2048 + k * 1024); } while (0)
#define PG8_CAT(x) __builtin_shufflevector(__builtin_bit_cast(i32x4, (x)[0]), __builtin_bit_cast(i32x4, (x)[1]), 0, 1, 2, 3, 4, 5, 6, 7)
#define PG8_MMA(ai, bj, At, Bt) do { __builtin_amdgcn_s_setprio(1); if constexpr (PROBE == 1) { asm volatile("" :: "v"(At[0][0]), "v"(At[3][1]), "v"(Bt[0][0]), "v"(Bt[1][1])); } else _Pragma("unroll") for (int m = 0; m < 4; ++m) _Pragma("unroll") for (int n = 0; n < 2; ++n) \
        asm volatile("v_mfma_f32_16x16x128_f8f6f4 %0, %1, %2, %0" : "+v"(acc[ai][bj][m][n]) : "v"(PG8_CAT(Bt[n])), "v"(PG8_CAT(At[m]))); __builtin_amdgcn_s_setprio(0); } while (0)
#define PG8_WAIT_V(n) asm volatile("s_waitcnt vmcnt(" #n ")" ::: "memory")
#define PG8_WAIT_L(n) asm volatile("s_waitcnt lgkmcnt(" #n ")" ::: "memory")
#define PG8_BAR __builtin_amdgcn_s_barrier()
#define PG8_SCHED __builtin_amdgcn_sched_barrier(0)
#define PG8_UT_FILL(u, slot) do { if (wid == 0) { const char *sa_, *sb_; S.srcs(u, lane, sa_, sb_); \
        __builtin_amdgcn_global_load_lds((const unsigned*)sa_, (PG8_LAS unsigned*)(utab + (slot) * 2048), 16, 0, 0); \
        __builtin_amdgcn_global_load_lds((const unsigned*)sb_, (PG8_LAS unsigned*)(utab + (slot) * 2048 + 1024), 16, 0, 0); } } while (0)
#define PG8_UT_OFFS(dst, slot) do { _Pragma("unroll") for (int _h = 0; _h < 2; ++_h) _Pragma("unroll") for (int _i = 0; _i < 2; ++_i) \
        dst[_h][_i] = *(const PG8_LAS unsigned*)(utab + (slot) * 2048 + (_h * HALF + R0 + 64 * _i) * 4) + (unsigned)C0 * 2u; } while (0)
    Unit cur, nxt; int ui = 0, cslot = 0;
    if (!S.next(0, cur)) return;
    f32x4 acc[2][2][4][2];
#pragma unroll
    for (int a = 0; a < 2; ++a)
#pragma unroll
        for (int b = 0; b < 2; ++b)
#pragma unroll
            for (int m = 0; m < 4; ++m)
#pragma unroll
                for (int n = 0; n < 2; ++n) acc[a][b][m][n] = (f32x4){0.f, 0.f, 0.f, 0.f};
    bf16x8 At[4][2], B0[2][2], B1[2][2];
    unsigned cOff[2][2], sOff[2][2];
    const char* cA = (const char*)g.A + (GATHER ? (size_t)0 : (size_t)cur.pm * tstep); const char* cB = (const char*)g.Bt + (size_t)cur.pn * tstep;
    PG8_UT_FILL(cur, 0); PG8_WAIT_V(0); PG8_BAR; asm volatile("" ::: "memory");
    if constexpr (GATHER) { PG8_UT_OFFS(cOff, 0); }
#pragma unroll
    for (int h = 0; h < 2; ++h)
#pragma unroll
        for (int i = 0; i < 2; ++i) { if (!GATHER) cOff[h][i] = 0u; sOff[h][i] = cOff[h][i]; }
    PG8_STAGE(PG8_SB(0, 0), cB, voffB); PG8_STAGE(PG8_SB(0, 1), cB + hstep, voffB); PG8_STAGE_A(0, 0, cA, cA, cOff); PG8_STAGE_A(0, 1, cA, cA, cOff);
    if (wr == 1) PG8_BAR;
    PG8_WAIT_V(2); PG8_BAR;
    PG8_STAGE(PG8_SB(1, 0), cB + kstep, voffB); PG8_STAGE_A(1, 0, cA + kstep, cA + kstep, cOff); PG8_STAGE(PG8_SB(1, 1), cB + hstep + kstep, voffB);
    PG8_WAIT_V(6); PG8_BAR;
    for (;;) {
        const bool has_next = S.next(ui + 1, nxt); const int nslot = cslot == 2 ? 0 : cslot + 1;
        if (has_next) PG8_UT_FILL(nxt, nslot);
        const char* nA = GATHER ? cA : (has_next ? (const char*)g.A + (size_t)nxt.pm * tstep : cA); const char* nB = has_next ? (const char*)g.Bt + (size_t)nxt.pn * tstep : cB;
        for (int t = 0; t < nt; t += 2) {
            const bool last = (t == nt - 2);
            const char* a1 = cA + (size_t)(t + 1) * kstep;
            const char* a2 = last ? nA : cA + (size_t)(t + 2) * kstep; const char* b2 = last ? nB : cB + (size_t)(t + 2) * kstep;
            const char* a3 = a2 + kstep; const char* b3 = b2 + kstep;
            if constexpr (GATHER) { if (last && has_next) { PG8_UT_OFFS(sOff, nslot); } }
            PG8_LDB(B0, 0, 0); PG8_LDB(B1, 0, 1); PG8_SCHED; PG8_LDA(At, 0, 0); PG8_STAGE_A(1, 1, a1, a1, cOff);
            PG8_WAIT_V(8); PG8_WAIT_L(0); PG8_BAR; PG8_MMA(0, 0, At, B0); PG8_MMA(0, 1, At, B1); PG8_BAR; PG8_SCHED;
            PG8_LDA(At, 0, 1); PG8_STAGE(PG8_SB(0, 0), b2, voffB); PG8_STAGE(PG8_SB(0, 1), b2 + hstep, voffB); PG8_STAGE_A(0, 0, a2, a2, sOff);
            PG8_WAIT_V(8); PG8_WAIT_L(0); PG8_BAR; PG8_MMA(1, 0, At, B0); PG8_MMA(1, 1, At, B1); PG8_BAR; PG8_SCHED;
            PG8_LDB(B0, 1, 0); PG8_LDB(B1, 1, 1); PG8_SCHED; PG8_LDA(At, 1, 0); PG8_STAGE_A(0, 1, a2, a2, sOff);
            PG8_WAIT_V(8); PG8_WAIT_L(0); PG8_BAR; PG8_MMA(0, 0, At, B0); PG8_MMA(0, 1, At, B1); PG8_BAR; PG8_SCHED;
            PG8_LDA(At, 1, 1); PG8_STAGE(PG8_SB(1, 0), b3, voffB); PG8_STAGE(PG8_SB(1, 1), b3 + hstep, voffB); PG8_STAGE_A(1, 0, a3, a3, sOff);
            PG8_WAIT_V(8); PG8_WAIT_L(0); PG8_BAR; PG8_MMA(1, 0, At, B0); PG8_MMA(1, 1, At, B1); PG8_BAR; PG8_SCHED;
        }
        if (wr == 0) PG8_BAR;
        asm volatile("s_nop 15\n\ts_nop 15" ::: "memory");
        E(acc, cur, wr, wc, fr, fq, (const PG8_LAS unsigned char*)(utab + cslot * 2048));
        if (!has_next) break;
#pragma unroll
        for (int a = 0; a < 2; ++a)
#pragma unroll
            for (int b = 0; b < 2; ++b)
#pragma unroll
                for (int m = 0; m < 4; ++m)
#pragma unroll
                    for (int n = 0; n < 2; ++n) acc[a][b][m][n] = (f32x4){0.f, 0.f, 0.f, 0.f};
        cur = nxt; cA = nA; cB = nB; ++ui; cslot = nslot;
#pragma unroll
        for (int h = 0; h < 2; ++h)
#pragma unroll
            for (int i = 0; i < 2; ++i) cOff[h][i] = sOff[h][i];
        if (wr == 1) PG8_BAR;
    }
    PG8_WAIT_V(0);
    PG8_BAR;
#undef PG8_SA
#undef PG8_SB
#undef PG8_STAGE
#undef PG8_STAGE_A
#undef PG8_LDA
#undef PG8_LDB
#undef PG8_CAT
#undef PG8_MMA
#undef PG8_WAIT_V
#undef PG8_WAIT_L
#undef PG8_BAR
#undef PG8_SCHED
#undef PG8_UT_FILL
#undef PG8_UT_OFFS
}
}
constexpr int NWAVES = 8;
constexpr int MKV_SHIFT = 2176 % 256;
constexpr int NTOK = 32768, DM = 2048, DPJ = 4352, SEQ = 4096, NMEM = 256, NEXP = 32;
constexpr int ZU = 0, ZV = 768, ZQ = 1536, ZK = 2304, ZW = 3072, ZM = 3840;
constexpr float LN_EPS = 1e-5f, DN_ALPHA = 1.189207115002721f, ATT_SCALE = 0.08838834764831845f;
constexpr int MAXTILES = 544, MAXROWS = MAXTILES * 256;
constexpr float W_SCALE = 64.0f, XS_SCALE = 8.0f, ACT_SCALE = 4.0f, YS_SCALE = 16.0f;
constexpr size_t MiB = 1u << 20;
constexpr size_t WS_CTL = 0, CTL_ZERO_BYTES = 1 * MiB;
constexpr size_t WS_WINT = 1 * MiB;
constexpr size_t WS_WMKVT = WS_WINT + 17 * MiB;
constexpr size_t WS_WOUTT = WS_WMKVT + 4 * MiB;
constexpr size_t WS_WGUT = WS_WOUTT + 8 * MiB;
constexpr size_t WS_WDT = WS_WGUT + 512 * MiB;
constexpr size_t WS_XB = WS_WDT + 256 * MiB;
constexpr size_t WS_MEMB = WS_XB + 128 * MiB;
constexpr size_t WS_Z = WS_MEMB + 8 * MiB;
constexpr size_t WS_MKV = WS_Z + 272 * MiB;
constexpr size_t WS_Y = WS_MKV + 4 * MiB;
constexpr size_t WS_H1 = WS_Y + 128 * MiB;
constexpr size_t WS_X1Q = WS_H1 + 256 * MiB;
constexpr size_t WS_XS = WS_X1Q + 128 * MiB;
constexpr size_t WS_ACT = WS_XS + 544 * MiB;
constexpr size_t WS_YS = WS_ACT + 544 * MiB;
constexpr size_t WS_LIST = WS_YS + 544 * MiB;
constexpr size_t WS_GATEL = WS_LIST + 4 * MiB;
constexpr size_t WS_ROWGATE = WS_GATEL + 4 * MiB;
constexpr size_t WS_SLOTROW = WS_ROWGATE + 1 * MiB;
constexpr size_t WS_WRF = WS_SLOTROW + 1 * MiB;
constexpr size_t WS_STATS = WS_WRF + 1 * MiB;
constexpr size_t WS_ROWOFF = WS_STATS + 1 * MiB;
constexpr size_t WS_END = WS_ROWOFF + 1 * MiB;
constexpr size_t WS_OATT = WS_XS;
constexpr size_t WS_LSE = WS_XS + 144 * MiB;
constexpr int CW_BAR = 4096;
constexpr int CW_CNT = 16384;
constexpr int RING_BYTES = 131072;
constexpr int LDSCTL_OFF = 143360;
constexpr int UTAB_OFF = 131072;
constexpr int LDS_BYTES = 147456;

#define GAS __attribute__((address_space(1)))
#define LAS __attribute__((address_space(3)))
typedef unsigned short bf16;
typedef unsigned v4u __attribute__((ext_vector_type(4)));
typedef unsigned v2u __attribute__((ext_vector_type(2)));
typedef float f32x4 __attribute__((ext_vector_type(4)));
#define LDS_WAIT() asm volatile("s_waitcnt lgkmcnt(0)" ::: "memory")
__device__ __forceinline__ unsigned pk2(float lo, float hi) { unsigned r; asm volatile("v_cvt_pk_bf16_f32 %0, %1, %2" : "=v"(r) : "v"(lo), "v"(hi)); return r; }
__device__ __forceinline__ float bflo(unsigned w) { return __uint_as_float(w << 16); }
__device__ __forceinline__ float bfhi(unsigned w) { return __uint_as_float(w & 0xffff0000u); }
__device__ __forceinline__ float wave_sum(float v) {
#pragma unroll
    for (int o = 1; o < 64; o <<= 1) v += __shfl_xor(v, o);
    return v;
}
__device__ __forceinline__ float wave_max(float v) {
#pragma unroll
    for (int o = 1; o < 64; o <<= 1) v = fmaxf(v, __shfl_xor(v, o));
    return v;
}
#define XB_TMO      128
#define XB_XCNT(j)  (256  + 64 * (j))
#define XB_XSUB(j)  (1280 + 64 * (j))
#define XB_XGEN(j)  (2304 + 64 * (j))
#define XB_TOP      3328
#define XB_TOPGEN   3392
#define XCD_BAR_WORDS 3456
#define XB_SPIN_CAP (1u << 18)

__device__ __forceinline__ unsigned xb_ld(unsigned* p)              { return __hip_atomic_load(p, __ATOMIC_RELAXED, __HIP_MEMORY_SCOPE_AGENT); }
__device__ __forceinline__ unsigned xb_add(unsigned* p, unsigned v) { return __hip_atomic_fetch_add(p, v, __ATOMIC_RELAXED, __HIP_MEMORY_SCOPE_AGENT); }
__device__ __forceinline__ unsigned xb_xcc_id() { return (unsigned)__builtin_amdgcn_s_getreg((3 << 11) | 20) & 0xFu; }
#define XB_SPIN(cond, bar) do { unsigned _sp = 0; while (cond) { __builtin_amdgcn_s_sleep(1); \
    if ((++_sp & 255u) == 0u) { if (xb_ld(&(bar)[XB_TMO])) break; if (_sp > XB_SPIN_CAP) { atomicAdd(&(bar)[XB_TMO], 1u); break; } } } } while (0)

struct XcdBarrier {
    unsigned* bar; unsigned x;
    volatile LAS unsigned* st;
};

__device__ __forceinline__ XcdBarrier xcd_barrier_post(unsigned* bar, volatile LAS unsigned* st) {
    XcdBarrier b; b.bar = bar; b.x = xb_xcc_id(); b.st = st;
    if (threadIdx.x == 0) (void)xb_add(&bar[XB_XCNT(b.x)], 1u);
    return b;
}
__device__ __forceinline__ void xcd_barrier_complete(unsigned* bar, unsigned x, unsigned& nloc, unsigned& nx) {
    const unsigned G = gridDim.x * gridDim.y * gridDim.z;
    unsigned sum, cnt, mine, sp = 0u;
    for (;;) {
        sum = 0u; cnt = 0u; mine = 0u;
#pragma unroll
        for (unsigned j = 0; j < 16; ++j) { const unsigned c = xb_ld(&bar[XB_XCNT(j)]); sum += c; cnt += (c > 0u) ? 1u : 0u; mine = (j == x) ? c : mine; }
        if (sum == G) break;
        __builtin_amdgcn_s_sleep(1);
        if ((++sp & 255u) == 0u) { if (xb_ld(&bar[XB_TMO])) break; if (sp > XB_SPIN_CAP) { atomicAdd(&bar[XB_TMO], 1u); break; } }
    }
    nloc = mine > 0u ? mine : 1u; nx = cnt > 0u ? cnt : 1u;
}

__device__ __forceinline__ void xcd_barrier(const XcdBarrier& b) {
    asm volatile("s_waitcnt vmcnt(0)" ::: "memory");
    __syncthreads();
    if (threadIdx.x == 0) {
        unsigned* bar = b.bar;
        __builtin_amdgcn_s_waitcnt(0);
        unsigned nloc = b.st[0], nx = b.st[1];
        if (nloc == 0u) { xcd_barrier_complete(bar, b.x, nloc, nx); b.st[0] = nloc; b.st[1] = nx; }
        const unsigned old = xb_add(&bar[XB_XSUB(b.x)], 1u);
        const unsigned gen = old / nloc;
        if (old + 1u == (gen + 1u) * nloc) {
            __builtin_amdgcn_fence(__ATOMIC_RELEASE, "agent");
            asm volatile("s_waitcnt vmcnt(0)" ::: "memory");
            const unsigned og = xb_add(&bar[XB_TOP], 1u);
            const unsigned tg = og / nx;
            if (og + 1u == (tg + 1u) * nx) xb_add(&bar[XB_TOPGEN], 1u);
            else XB_SPIN(xb_ld(&bar[XB_TOPGEN]) == tg, bar);
            __builtin_amdgcn_fence(__ATOMIC_ACQUIRE, "agent");
            xb_add(&bar[XB_XGEN(b.x)], 1u);
            asm volatile("s_waitcnt vmcnt(0)" ::: "memory");
        } else {
            XB_SPIN(xb_ld(&bar[XB_XGEN(b.x)]) == gen, bar);
            __builtin_amdgcn_fence(__ATOMIC_ACQUIRE, "agent");
            asm volatile("s_waitcnt vmcnt(0)" ::: "memory");
        }
    }
    __syncthreads();
}
struct Args { const float* in[22]; float* out; unsigned char* ws; int ph_lo, ph_hi; };
enum { I_X = 0, I_MEM, I_WIN, I_WSP, I_BSP, I_ALNG, I_ALNB, I_WMKV, I_NAG, I_NBG, I_NMG, I_WOUT, I_LN1G, I_LN1B, I_WR, I_BR, I_WGU, I_BGU, I_WD, I_BD, I_LN2G, I_LN2B };

__device__ __forceinline__ void tr_item(const float* __restrict__ W, int N, bf16* WT, int k0, int n0, int drow0, const float* ga, const float* gb, const float* gm, LAS float* scr, int lane) {
    float tv[32];
#pragma unroll
    for (int i = 0; i < 32; ++i) tv[i] = W[(size_t)(k0 + 2 * i + (lane >> 5)) * N + n0 + (lane & 31)];
    if (ga) { const float* gp = (k0 < 768) ? ga + k0 : (k0 < 1536 ? gb + (k0 - 768) : gm + (k0 - 1536)); float gv[32];
#pragma unroll
        for (int i = 0; i < 32; ++i) gv[i] = gp[2 * i + (lane >> 5)];
#pragma unroll
        for (int i = 0; i < 32; ++i) tv[i] *= gv[i]; }
#pragma unroll
    for (int i = 0; i < 32; ++i) scr[(2 * i + (lane >> 5)) * 33 + (lane & 31)] = tv[i];
    LDS_WAIT(); asm volatile("" ::: "memory");
    const int c = lane & 7;
#pragma unroll
    for (int j = 0; j < 4; ++j) { const int n = (lane >> 3) + 8 * j; const LAS float* s = scr + (8 * c) * 33 + n;
        v4u o; o.x = pk2(s[0 * 33], s[1 * 33]); o.y = pk2(s[2 * 33], s[3 * 33]); o.z = pk2(s[4 * 33], s[5 * 33]); o.w = pk2(s[6 * 33], s[7 * 33]);
        *(v4u*)(WT + (size_t)(drow0 + n) * 2048 + k0 + 8 * c) = o; }
    LDS_WAIT(); asm volatile("" ::: "memory");
}
__device__ __forceinline__ unsigned pk4_fp8(float a, float b, float c, float d) { int r = __builtin_amdgcn_cvt_pk_fp8_f32(a, b, 0, false); r = __builtin_amdgcn_cvt_pk_fp8_f32(c, d, r, true); return (unsigned)r; }
__device__ __forceinline__ void tr_item_fp8(const float* __restrict__ W, int N, unsigned char* WT, int k0, int n0, int drow0, float scale, LAS float* scr, int lane) {
    float tv[32];
#pragma unroll
    for (int i = 0; i < 32; ++i) tv[i] = W[(size_t)(k0 + 2 * i + (lane >> 5)) * N + n0 + (lane & 31)];
#pragma unroll
    for (int i = 0; i < 32; ++i) scr[(2 * i + (lane >> 5)) * 33 + (lane & 31)] = tv[i] * scale;
    LDS_WAIT(); asm volatile("" ::: "memory");
    const int c = lane & 7;
#pragma unroll
    for (int j = 0; j < 4; ++j) { const int n = (lane >> 3) + 8 * j; const LAS float* s = scr + (8 * c) * 33 + n;
        v2u o; o.x = pk4_fp8(s[0 * 33], s[1 * 33], s[2 * 33], s[3 * 33]); o.y = pk4_fp8(s[4 * 33], s[5 * 33], s[6 * 33], s[7 * 33]);
        *(v2u*)(WT + (size_t)(drow0 + n) * 2048 + k0 + 8 * c) = o; }
    LDS_WAIT(); asm volatile("" ::: "memory");
}
struct MoeItem { const float* W; unsigned char* WT; int N, k0, n0, drow0; };
__device__ __forceinline__ MoeItem moe_item(const Args& a, int it) {
    constexpr int I_GU1 = 32 * 128, I_DN1 = 32 * 64; MoeItem m; unsigned char* ws = a.ws; int r = it;
    if (r < 32 * I_GU1) { const int e = r / I_GU1, rr = r % I_GU1, kb = rr / 128, nb = rr % 128, n0 = 32 * nb; const int s = n0 >> 11, jj = n0 & 2047;
        m.W = a.in[I_WGU] + (size_t)e * 2048 * 4096; m.N = 4096; m.WT = ws + WS_WGUT; m.k0 = 64 * kb; m.n0 = n0; m.drow0 = e * 4096 + 256 * (jj >> 7) + 128 * s + (jj & 127); return m; }
    r -= 32 * I_GU1; { const int e = r / I_DN1, rr = r % I_DN1, kb = rr / 64, nb = rr % 64;
        m.W = a.in[I_WD] + (size_t)e * 2048 * 2048; m.N = 2048; m.WT = ws + WS_WDT; m.k0 = 64 * kb; m.n0 = 32 * nb; m.drow0 = e * 2048 + 32 * nb; return m; }
}
__device__ __forceinline__ void moe_conv_lds(const Args& a, LAS unsigned char* lds, int lane, int wave, int gw, int NGW) {
    LAS float* scr = (LAS float*)(lds + wave * 16384);
    constexpr int NIT = 32 * (32 * 128 + 32 * 64);
#define MC_LOAD(M_, TV) do { _Pragma("unroll") for (int i = 0; i < 32; ++i) TV[i] = M_.W[(size_t)(M_.k0 + 2 * i + (lane >> 5)) * M_.N + M_.n0 + (lane & 31)]; } while (0)
#define MC_STORE(M_, TV) do { _Pragma("unroll") for (int i = 0; i < 32; ++i) scr[(2 * i + (lane >> 5)) * 33 + (lane & 31)] = TV[i] * W_SCALE; \
        LDS_WAIT(); asm volatile("" ::: "memory"); const int c = lane & 7; \
        _Pragma("unroll") for (int j = 0; j < 4; ++j) { const int n = (lane >> 3) + 8 * j; const LAS float* s = scr + (8 * c) * 33 + n; \
            v2u o; o.x = pk4_fp8(s[0 * 33], s[1 * 33], s[2 * 33], s[3 * 33]); o.y = pk4_fp8(s[4 * 33], s[5 * 33], s[6 * 33], s[7 * 33]); \
            *(v2u*)(M_.WT + (size_t)(M_.drow0 + n) * 2048 + M_.k0 + 8 * c) = o; } \
        LDS_WAIT(); asm volatile("" ::: "memory"); } while (0)
#define MC_NEXT(I_) (((I_) + NGW < NIT) ? (I_) + NGW : (I_))
    int cur = gw; if (cur >= NIT) return;
    float tA[32], tB[32]; int n1 = MC_NEXT(cur);
    MoeItem mA = moe_item(a, cur), mB = moe_item(a, n1);
    MC_LOAD(mA, tA);
    for (;;) {
        MC_LOAD(mB, tB); asm volatile("" ::: "memory");
        MC_STORE(mA, tA);
        if (n1 == cur) break;
        cur = n1; n1 = MC_NEXT(n1); mA = moe_item(a, n1);
        MC_LOAD(mA, tA); asm volatile("" ::: "memory");
        MC_STORE(mB, tB);
        if (n1 == cur) break;
        cur = n1; n1 = MC_NEXT(n1); mB = moe_item(a, n1);
    }
#undef MC_LOAD
#undef MC_STORE
#undef MC_NEXT
}
__device__ __forceinline__ void p0_prep(const Args& a, LAS unsigned char* lds, int tid, int lane, int wave, int vcu, int G) {
    unsigned char* ws = a.ws;
    {
        const size_t n8x = (size_t)NTOK * DM / 8, n8m = (size_t)2048 * 2048 / 8;
        const size_t NT8 = n8x + n8m, st8 = (size_t)G * 512;
        for (size_t i0 = (size_t)vcu * 512 + tid; i0 < NT8; i0 += 4 * st8) { f32x4 p[4], q[4];
#pragma unroll
            for (int u = 0; u < 4; ++u) { const size_t i = i0 + u * st8; if (i < NT8) { const float* src = i < n8x ? a.in[I_X] + 8 * i : a.in[I_MEM] + 8 * (i - n8x); p[u] = *(const f32x4*)src; q[u] = *(const f32x4*)(src + 4); } }
#pragma unroll
            for (int u = 0; u < 4; ++u) { const size_t i = i0 + u * st8; if (i < NT8) { bf16* dst = i < n8x ? (bf16*)(ws + WS_XB) + 8 * i : (bf16*)(ws + WS_MEMB) + 8 * (i - n8x);
                v4u o; o.x = pk2(p[u][0], p[u][1]); o.y = pk2(p[u][2], p[u][3]); o.z = pk2(q[u][0], q[u][1]); o.w = pk2(q[u][2], q[u][3]);
                *(v4u*)dst = o; } } }
    }
    {
        bf16* WRB = (bf16*)(ws + WS_WRF); float* C12 = (float*)(ws + WS_WRF + 512 * 1024); bf16* GB16 = (bf16*)(ws + WS_WRF + 768 * 1024); const float* wr = a.in[I_WR]; const float* lg = a.in[I_LN1G]; const float* lb = a.in[I_LN1B];
        for (int idx = vcu * 512 + tid; idx < 65536; idx += G * 512) { const int jj = idx & 7, ln = (idx >> 3) & 63, nt = (idx >> 9) & 1, s = idx >> 10;
            const int k = 32 * s + 8 * (ln >> 4) + jj, e = 16 * nt + (ln & 15); const float w = lg[k] * wr[k * 32 + e]; const unsigned hi = pk2(w, 0.f) & 0xffffu; const float rem = w - __uint_as_float(hi << 16);
            WRB[(size_t)((s * 2 + nt) * 2 + 0) * 512 + ln * 8 + jj] = (bf16)hi; WRB[(size_t)((s * 2 + nt) * 2 + 1) * 512 + ln * 8 + jj] = (bf16)(pk2(rem, 0.f) & 0xffffu); }
        for (int k = vcu * 512 + tid; k < 2048; k += G * 512) { GB16[k] = (bf16)(pk2(lg[k], 0.f) & 0xffffu); GB16[2048 + k] = (bf16)(pk2(lb[k] * XS_SCALE, 0.f) & 0xffffu); }
        if (vcu == 0) { LAS float* red = (LAS float*)lds; const int e = tid & 31, kr = tid >> 5; float s1 = 0.f, s2 = 0.f;
#pragma unroll 1
            for (int kb = kr * 128; kb < kr * 128 + 128; kb += 16) { float wv[16], gv[16], bv[16];
#pragma unroll
                for (int j = 0; j < 16; ++j) { wv[j] = wr[(kb + j) * 32 + e]; gv[j] = lg[kb + j]; bv[j] = lb[kb + j]; }
#pragma unroll
                for (int j = 0; j < 16; ++j) { s1 += gv[j] * wv[j]; s2 += bv[j] * wv[j]; } }
            red[kr * 32 + e] = s1; red[512 + kr * 32 + e] = s2; __syncthreads();
            if (tid < 32) { float t1 = 0.f, t2 = 0.f; for (int j = 0; j < 16; ++j) { t1 += red[j * 32 + tid]; t2 += red[512 + j * 32 + tid]; } C12[tid] = t1; C12[32 + tid] = t2 + a.in[I_BR][tid]; }
            __syncthreads(); } }
    LAS float* scr = (LAS float*)(lds + wave * 16384);
    const int gw = vcu * NWAVES + wave, NGW = G * NWAVES;
    constexpr int I_IN = 32 * 136, I_MKV = 32 * 32, I_OUT = 32 * 64, I_GU1 = 32 * 128, I_DN1 = 32 * 64;
    constexpr int NITEMS = I_IN + I_MKV + I_OUT;
    for (int it = gw; it < NITEMS; it += NGW) {
        int r = it;
        if (r < I_IN) { tr_item(a.in[I_WIN], DPJ, (bf16*)(ws + WS_WINT), 64 * (r / 136), 32 * (r % 136), 32 * (r % 136), nullptr, nullptr, nullptr, scr, lane); continue; } r -= I_IN;
        if (r < I_MKV) { tr_item(a.in[I_WMKV], 1024, (bf16*)(ws + WS_WMKVT), 64 * (r / 32), 32 * (r % 32), 32 * (r % 32), nullptr, nullptr, nullptr, scr, lane); continue; } r -= I_MKV;
        { tr_item(a.in[I_WOUT], 2048, (bf16*)(ws + WS_WOUTT), 64 * (r / 64), 32 * (r % 64), 32 * (r % 64), a.in[I_NAG], a.in[I_NBG], a.in[I_NMG], scr, lane); }
    }
}

__device__ __forceinline__ void moe_table(const Args& a, LAS int* tb, LAS int* cn, int tid) {
    const unsigned* ctl = (const unsigned*)(a.ws + WS_CTL);
    if (tid < 64) {
        const int e = tid & 31; const int c = (tid < 32) ? (int)__hip_atomic_load(ctl + CW_CNT + 64 * e, __ATOMIC_RELAXED, __HIP_MEMORY_SCOPE_AGENT) : 0;
        const int tiles = (c + 255) >> 8; int x = tiles;
#pragma unroll
        for (int o = 1; o < 32; o <<= 1) { const int y = __shfl_up(x, o); if (tid >= o) x += y; }
        if (tid < 32) { tb[e] = x - tiles; cn[e] = c; if (e == 31) tb[32] = x; } }
    __syncthreads();
}
__device__ __forceinline__ void p6_tables(const Args& a, LAS int* tb, LAS int* cn, int tid, int vcu, int G) {
    const int* LIST = (const int*)(a.ws + WS_LIST); const float* GATEL = (const float*)(a.ws + WS_GATEL);
    unsigned* ROWOFF = (unsigned*)(a.ws + WS_ROWOFF); float* ROWGATE = (float*)(a.ws + WS_ROWGATE); int* SLOTROW = (int*)(a.ws + WS_SLOTROW);
    const int nrows = tb[32] * 256;
    for (int grow = vcu * 512 + tid; grow < nrows; grow += G * 512) { const int tile = grow >> 8; int e = 0;
#pragma unroll
        for (int j = 1; j < 32; ++j) e += (tb[j] <= tile) ? 1 : 0;
        const int rank = grow - tb[e] * 256;
        if (rank < cn[e]) { const int entry = LIST[(size_t)e * NTOK + rank]; ROWOFF[grow] = (unsigned)(entry >> 2) * (unsigned)DM; ROWGATE[grow] = GATEL[(size_t)e * NTOK + rank]; SLOTROW[entry] = grow; }
        else { ROWOFF[grow] = 0u; ROWGATE[grow] = 0.f; } }
}
__device__ __forceinline__ void p8_final(const Args& a, LAS unsigned char* lds, int tid, int lane, int wave, int vcu, int G) {
    const bf16* X1 = (const bf16*)(a.ws + WS_H1); const unsigned char* YS = a.ws + WS_YS; const int* SLOTROW = (const int*)(a.ws + WS_SLOTROW);
    const float* STATS = (const float*)(a.ws + WS_STATS);
    typedef int p9i4 __attribute__((ext_vector_type(4))); typedef float f32x2_t __attribute__((ext_vector_type(2)));
    LAS f32x4* gl = (LAS f32x4*)lds;
    for (int u = tid; u < 512; u += NWAVES * 64) { gl[u] = ((const f32x4*)a.in[I_LN1G])[u]; gl[512 + u] = ((const f32x4*)a.in[I_LN1B])[u] * DN_ALPHA; gl[1024 + u] = ((const f32x4*)a.in[I_LN2G])[u]; gl[1536 + u] = ((const f32x4*)a.in[I_LN2B])[u]; }
    __syncthreads();
    const int gw = vcu * NWAVES + wave, NGW = G * NWAVES;
#define P9_SR(DST, ROW) do { const __attribute__((address_space(1))) p9i4* srp_ = (const __attribute__((address_space(1))) p9i4*)(SLOTROW + (size_t)(ROW) * 4); asm volatile("" : "+v"(srp_)); DST = *srp_; } while (0)
#define P9_ISSUE(ROW, SR, H, Y, M, R) do { const v2u* xp_ = (const v2u*)(X1 + (size_t)(ROW) * DM) + lane; M = STATS[2 * (ROW)]; R = STATS[2 * (ROW) + 1]; \
        _Pragma("unroll") for (int j = 0; j < 8; ++j) H[j] = xp_[64 * j]; \
        _Pragma("unroll") for (int k = 0; k < 4; ++k) { const unsigned* yp_ = (const unsigned*)(YS + (size_t)__builtin_amdgcn_readfirstlane(SR[k]) * DM) + lane; _Pragma("unroll") for (int j = 0; j < 8; ++j) Y[k][j] = yp_[64 * j]; } } while (0)
#define P9_COMPUTE(ROW, H, Y, M, R) do { f32x4 v[8]; \
        _Pragma("unroll") for (int j = 0; j < 8; ++j) { const f32x4 gg = gl[lane + 64 * j], bb = gl[512 + lane + 64 * j]; const v2u hw = H[j]; \
            v[j] = ((f32x4){bflo(hw.x), bfhi(hw.x), bflo(hw.y), bfhi(hw.y)} - M) * (R * DN_ALPHA) * gg + bb; } \
        __builtin_amdgcn_sched_barrier(0); \
        _Pragma("unroll") for (int k = 0; k < 4; ++k) { _Pragma("unroll") for (int j = 0; j < 8; ++j) { int w = (int)Y[k][j]; asm volatile("" : "+v"(w)); const f32x2_t lo = __builtin_amdgcn_cvt_pk_f32_fp8(w, false), hi = __builtin_amdgcn_cvt_pk_f32_fp8(w, true); \
                v[j][0] += lo[0] * (1.0f / YS_SCALE); v[j][1] += lo[1] * (1.0f / YS_SCALE); v[j][2] += hi[0] * (1.0f / YS_SCALE); v[j][3] += hi[1] * (1.0f / YS_SCALE); asm volatile("" : "+v"(v[j])); } } \
        float s = 0.f; \
        _Pragma("unroll") for (int j = 0; j < 8; ++j) s += (v[j][0] + v[j][1]) + (v[j][2] + v[j][3]); \
        const float mean = wave_sum(s) * (1.0f / DM); float q = 0.f; \
        _Pragma("unroll") for (int j = 0; j < 8; ++j) { v[j] = v[j] - mean; q += (v[j][0] * v[j][0] + v[j][1] * v[j][1]) + (v[j][2] * v[j][2] + v[j][3] * v[j][3]); } \
        const float rstd = 1.0f / sqrtf(wave_sum(q) * (1.0f / DM) + LN_EPS); \
        __builtin_amdgcn_sched_barrier(0); \
        f32x4* op = (f32x4*)(a.out + (size_t)(ROW) * DM) + lane; \
        _Pragma("unroll") for (int j = 0; j < 8; ++j) { const f32x4 gg = gl[1024 + lane + 64 * j], bb = gl[1536 + lane + 64 * j]; op[64 * j] = v[j] * rstd * gg + bb; } } while (0)
#define P9_NEXT(R_) (((R_) + NGW < NTOK) ? (R_) + NGW : (R_))
    int cur = gw; if (cur >= NTOK) return;
    v2u hA[8], hB[8]; unsigned yA[4][8], yB[4][8]; float mA, rA, mB, rB; p9i4 srA, srB;
    int n1 = P9_NEXT(cur), n2 = P9_NEXT(n1);
    P9_SR(srA, cur); P9_SR(srB, n1);
    P9_ISSUE(cur, srA, hA, yA, mA, rA);
    P9_SR(srA, n2); P9_ISSUE(n1, srB, hB, yB, mB, rB);
    asm volatile("" ::: "memory");
    P9_COMPUTE(cur, hA, yA, mA, rA);
    bool more = (n1 != cur);
    while (more) {
        cur = n1; n1 = n2; n2 = P9_NEXT(n1);
        P9_SR(srB, n2); P9_ISSUE(n1, srA, hA, yA, mA, rA);
        asm volatile("" ::: "memory");
        P9_COMPUTE(cur, hB, yB, mB, rB);
        if (n1 == cur) break;
        cur = n1; n1 = n2; n2 = P9_NEXT(n1);
        P9_SR(srA, n2); P9_ISSUE(n1, srB, hB, yB, mB, rB);
        asm volatile("" ::: "memory");
        P9_COMPUTE(cur, hA, yA, mA, rA);
        more = (n1 != cur);
    }
#undef P9_NEXT
#undef P9_ISSUE
#undef P9_SR
#undef P9_COMPUTE
}
typedef short bf16x8_t __attribute__((ext_vector_type(8)));
typedef short s16x4_t __attribute__((ext_vector_type(4)));
struct AttBlk { const bf16* q; const bf16* k; const bf16* v; long qstride, kstride; bf16* o; long ostride; float* lse; long lstride; int first; };
constexpr int NBLK_DIL = 3 * 8 * 6 * 32, NBLK_CROSS = 8 * 4 * 32;
__device__ __forceinline__ void p2b_combine(const Args& a, int lane, int wave, int vcu, int G) {
    const bf16* OATT = (const bf16*)(a.ws + WS_OATT); const float* LSE = (const float*)(a.ws + WS_LSE); bf16* Y = (bf16*)(a.ws + WS_Y);
    const int gw = vcu * NWAVES + wave, NGW = G * NWAVES;
#define P3_ISSUE(TOK, L, W, MY) do { \
        _Pragma("unroll") for (int j = 0; j < 3; ++j) { const int h = 2 * j + (lane >> 5), d = 4 * lane + 256 * j; \
            _Pragma("unroll") for (int p = 0; p < 3; ++p) { L[j][p] = LSE[((long)p * NTOK + (TOK)) * 6 + h]; W[j][p] = *(const v2u*)(OATT + ((long)p * NTOK + (TOK)) * 768 + d); } } \
        _Pragma("unroll") for (int j = 0; j < 2; ++j) MY[j] = *(const v2u*)(Y + (long)(TOK) * DM + 1536 + 4 * lane + 256 * j); } while (0)
#define P3_COMPUTE(TOK, L, W, MY) do { float o[3][4]; float ss = 0.f; \
        _Pragma("unroll") for (int j = 0; j < 3; ++j) { float l0 = L[j][0], l1 = L[j][1], l2 = L[j][2]; \
            const float m = fmaxf(l0, fmaxf(l1, l2)); l0 = __expf(l0 - m); l1 = __expf(l1 - m); l2 = __expf(l2 - m); const float inv = 1.0f / (l0 + l1 + l2); l0 *= inv; l1 *= inv; l2 *= inv; \
            const v2u w0 = W[j][0], w1 = W[j][1], w2 = W[j][2]; \
            o[j][0] = l0 * bflo(w0.x) + l1 * bflo(w1.x) + l2 * bflo(w2.x); o[j][1] = l0 * bfhi(w0.x) + l1 * bfhi(w1.x) + l2 * bfhi(w2.x); \
            o[j][2] = l0 * bflo(w0.y) + l1 * bflo(w1.y) + l2 * bflo(w2.y); o[j][3] = l0 * bfhi(w0.y) + l1 * bfhi(w1.y) + l2 * bfhi(w2.y); \
            ss += (o[j][0] * o[j][0] + o[j][1] * o[j][1]) + (o[j][2] * o[j][2] + o[j][3] * o[j][3]); } \
        const float rstd = 1.0f / sqrtf(wave_sum(ss) * (1.0f / 768.0f) + LN_EPS); \
        _Pragma("unroll") for (int j = 0; j < 3; ++j) { v2u w; w.x = pk2(o[j][0] * rstd, o[j][1] * rstd); w.y = pk2(o[j][2] * rstd, o[j][3] * rstd); *(v2u*)(Y + (long)(TOK) * DM + 768 + 4 * lane + 256 * j) = w; } \
        float m[2][4]; float sm = 0.f; \
        _Pragma("unroll") for (int j = 0; j < 2; ++j) { const v2u w = MY[j]; m[j][0] = bflo(w.x); m[j][1] = bfhi(w.x); m[j][2] = bflo(w.y); m[j][3] = bfhi(w.y); \
            sm += (m[j][0] * m[j][0] + m[j][1] * m[j][1]) + (m[j][2] * m[j][2] + m[j][3] * m[j][3]); } \
        const float rm = 1.0f / sqrtf(wave_sum(sm) * (1.0f / 512.0f) + LN_EPS); \
        _Pragma("unroll") for (int j = 0; j < 2; ++j) { v2u w; w.x = pk2(m[j][0] * rm, m[j][1] * rm); w.y = pk2(m[j][2] * rm, m[j][3] * rm); *(v2u*)(Y + (long)(TOK) * DM + 1536 + 4 * lane + 256 * j) = w; } } while (0)
#define P3_NEXT(R_) (((R_) + NGW < NTOK) ? (R_) + NGW : (R_))
    int cur = gw; if (cur >= NTOK) return;
    float lA[3][3], lB[3][3]; v2u wA[3][3], wB[3][3], yA[2], yB[2];
    int n1 = P3_NEXT(cur);
    P3_ISSUE(cur, lA, wA, yA);
    P3_ISSUE(n1, lB, wB, yB);
    asm volatile("" ::: "memory");
    P3_COMPUTE(cur, lA, wA, yA);
    bool more = (n1 != cur);
    while (more) {
        cur = n1; n1 = P3_NEXT(n1);
        P3_ISSUE(n1, lA, wA, yA);
        asm volatile("" ::: "memory");
        P3_COMPUTE(cur, lB, wB, yB);
        if (n1 == cur) break;
        cur = n1; n1 = P3_NEXT(n1);
        P3_ISSUE(n1, lB, wB, yB);
        asm volatile("" ::: "memory");
        P3_COMPUTE(cur, lA, wA, yA);
        more = (n1 != cur);
    }
#undef P3_NEXT
#undef P3_ISSUE
#undef P3_COMPUTE
}
constexpr int A2_VOFF = 65536;
__device__ __forceinline__ void a2_loadq(v4u (&qf)[4], const bf16* q, long qstride, int wave, int l15, int g) {
    const bf16* p = q + (long)(wave * 16 + l15) * qstride + g * 8;
    asm volatile("global_load_dwordx4 %0, %4, off\n\tglobal_load_dwordx4 %1, %4, off offset:64\n\tglobal_load_dwordx4 %2, %4, off offset:128\n\tglobal_load_dwordx4 %3, %4, off offset:192"
                 : "=&v"(qf[0]), "=&v"(qf[1]), "=&v"(qf[2]), "=&v"(qf[3]) : "v"(p) : "memory");
}
struct A3Blk { AttBlk B; int masked, p, ldprev, ldcur; };
__device__ __forceinline__ void a3_desc(const Args& a, int item, int pos, A3Blk& D) {
    const bf16* Z = (const bf16*)(a.ws + WS_Z); const bf16* MKV = (const bf16*)(a.ws + WS_MKV); bf16* Y = (bf16*)(a.ws + WS_Y); bf16* OATT = (bf16*)(a.ws + WS_OATT); float* LSE = (float*)(a.ws + WS_LSE);
    AttBlk& B = D.B; int pat, ci;
    if (item < 384) { pat = 0; ci = item; } else if (item < 768) { pat = 1; ci = item - 384; } else if (item < 1024) { pat = 3; ci = item - 768; } else { pat = 2; ci = item - 1024; }
    if (pat < 3) { int b, h, r, n;
        if (pat == 2) { b = ci / 96; const int rem = ci % 96; h = rem >> 4; r = rem & 15; n = pos; }
        else { b = ci / 48; const int rem = ci % 48; h = rem >> 3; const int c8 = rem & 7; if (pat == 0) { r = 0; n = c8 * 4 + pos; } else { r = c8 >> 1; n = (c8 & 1) * 4 + pos; } }
        const int dil = 1 << (2 * pat); const long tq = (long)b * SEQ + (long)128 * n * dil + r, tk = tq - (long)128 * dil;
        B.q = Z + tq * DPJ + ZQ + h * 128; B.k = Z + tk * DPJ + ZK + h * 128; B.v = Z + tk * DPJ + ZW + h * 128; B.qstride = (long)dil * DPJ; B.kstride = (long)dil * DPJ;
        B.o = OATT + ((long)pat * NTOK + tq) * 768 + h * 128; B.ostride = (long)dil * 768; B.lse = LSE + ((long)pat * NTOK + tq) * 6 + h; B.lstride = (long)dil * 6; B.first = (n == 0);
        D.masked = 1; D.p = pos; D.ldprev = (pos == 0); D.ldcur = 1; }
    else { const int b = ci >> 5, h = (ci >> 3) & 3, n = (ci & 7) * 4 + pos; const long tq = (long)b * SEQ + 128 * n;
        B.q = Z + tq * DPJ + ZM + h * 128; B.k = MKV + (long)b * NMEM * 1024 + h * 128; B.v = B.k + 512; B.qstride = DPJ; B.kstride = 1024;
        B.o = Y + tq * DM + 1536 + h * 128; B.ostride = DM; B.lse = nullptr; B.lstride = 0; B.first = 0;
        D.masked = 0; D.p = 0; D.ldprev = (pos == 0); D.ldcur = (pos == 0); }
}
__device__ __forceinline__ int a3_chainlen(int item) { return (item >= 1024) ? 2 : 4; }
template <bool KIMG>
__device__ __forceinline__ void a3_stage_half(LAS unsigned char* img, const bf16* base, long stride, int first, int half, int slot, int lane, int wave) {
    const int rlo = lane >> 4, cp = lane & 15;
#pragma unroll
    for (int i = 0; i < 4; ++i) { const int row = half * 128 + (wave * 4 + i) * 4 + rlo, rr = (first && row < 128) ? 128 : row; const int ch = cp ^ (KIMG ? (((i & 3) << 2) | rlo) : ((rlo << 2) | (i & 3)));
        __builtin_amdgcn_global_load_lds((const unsigned*)(base + (long)rr * stride + ch * 8), (LAS unsigned*)(img + slot * 32768 + (wave * 4 + i) * 1024), 16, 0, 0); }
}
template <bool KIMG>
__device__ __forceinline__ void a3_stage(LAS unsigned char* img, const bf16* base, const A3Blk& D, int lane, int wave) {
    if (D.ldprev) a3_stage_half<KIMG>(img, base, D.B.kstride, D.B.first, 0, D.p & 1, lane, wave);
    if (D.ldcur) a3_stage_half<KIMG>(img, base, D.B.kstride, D.B.first, 1, (D.p + 1) & 1, lane, wave);
}
#define A3_TILE(kt, p) (((((kt) >> 3) + (p)) & 1) * 32768 + ((kt) & 7) * 4096)
template <bool MASKED>
__device__ __forceinline__ void a3_qk(LAS unsigned char* lds, const v4u (&qf)[4], f32x4 (&st)[16], int p, int wave, int l15, int g) {
    constexpr int NT = MASKED ? 9 : 16; const int x = l15;
    int koff[4];
#pragma unroll
    for (int ds = 0; ds < 4; ++ds) koff[ds] = 256 * l15 + 16 * ((4 * ds + g) ^ x);
    bf16x8_t kA[2][4], kB[2][4];
#define A3_KLOAD2(DST, I_) do { _Pragma("unroll") for (int u_ = 0; u_ < 2; ++u_) if ((I_) + u_ < NT) { const int kt_ = MASKED ? min(wave + (I_) + u_, 15) : (I_) + u_; const int tb_ = A3_TILE(kt_, p); \
        _Pragma("unroll") for (int ds = 0; ds < 4; ++ds) DST[u_][ds] = *(const LAS bf16x8_t*)(lds + tb_ + koff[ds]); } } while (0)
#define A3_KMMA2(SRC, I_) do { f32x4 a0_ = {0.f, 0.f, 0.f, 0.f}, a1_ = {0.f, 0.f, 0.f, 0.f}; \
        _Pragma("unroll") for (int ds = 0; ds < 4; ++ds) { a0_ = __builtin_amdgcn_mfma_f32_16x16x32_bf16(SRC[0][ds], __builtin_bit_cast(bf16x8_t, qf[ds]), a0_, 0, 0, 0); \
            if ((I_) + 1 < NT) a1_ = __builtin_amdgcn_mfma_f32_16x16x32_bf16(SRC[1][ds], __builtin_bit_cast(bf16x8_t, qf[ds]), a1_, 0, 0, 0); } \
        st[(I_)] = a0_; if ((I_) + 1 < NT) st[(I_) + 1] = a1_; } while (0)
    A3_KLOAD2(kA, 0);
#pragma unroll
    for (int ip = 0; ip < NT; ip += 4) {
        if (ip + 2 < NT) A3_KLOAD2(kB, ip + 2);
        __builtin_amdgcn_sched_barrier(0);
        A3_KMMA2(kA, ip);
        if (ip + 2 < NT) {
            if (ip + 4 < NT) A3_KLOAD2(kA, ip + 4);
            __builtin_amdgcn_sched_barrier(0);
            A3_KMMA2(kB, ip + 2); }
        __builtin_amdgcn_sched_barrier(0);
    }
#undef A3_KLOAD2
#undef A3_KMMA2
}
template <bool MASKED>
__device__ __forceinline__ void a3_softmax_pv(LAS unsigned char* lds, f32x4 (&st)[16], const AttBlk& B, int p, int wave, int lane, int l15, int g) {
    constexpr int NT = MASKED ? 10 : 16, NTQ = MASKED ? 9 : 16;
    float mx = -INFINITY;
    if (MASKED) { const int qi = wave * 16 + l15;
#pragma unroll
        for (int j = 0; j < 4; ++j) { if ((wave + 0) * 16 + 4 * g + j < qi) st[0][j] = -INFINITY; if ((wave + 8) * 16 + 4 * g + j > qi + 128 || wave + 8 > 15) st[8][j] = -INFINITY; }
        if (B.first) {
#pragma unroll
            for (int i = 0; i < NTQ; ++i) if (wave + i < 8) st[i] = (f32x4){-INFINITY, -INFINITY, -INFINITY, -INFINITY}; } }
#pragma unroll
    for (int i = 0; i < NTQ; ++i) mx = fmaxf(mx, fmaxf(fmaxf(st[i][0], st[i][1]), fmaxf(st[i][2], st[i][3])));
    mx = fmaxf(mx, __shfl_xor(mx, 16)); mx = fmaxf(mx, __shfl_xor(mx, 32));
    constexpr float C2 = ATT_SCALE * 1.4426950408889634f; unsigned pp[NT][2];
    typedef float f32x2_t __attribute__((ext_vector_type(2))); typedef __bf16 bf16x2_t __attribute__((ext_vector_type(2)));
    const float mxc = -mx * C2; f32x2_t sum2 = {0.f, 0.f};
#pragma unroll
    for (int i = 0; i < NTQ; ++i) { const f32x2_t a = (f32x2_t){st[i][0], st[i][1]} * C2 + mxc, b = (f32x2_t){st[i][2], st[i][3]} * C2 + mxc;
        f32x2_t pa, pb; pa.x = __builtin_amdgcn_exp2f(a.x); pa.y = __builtin_amdgcn_exp2f(a.y); pb.x = __builtin_amdgcn_exp2f(b.x); pb.y = __builtin_amdgcn_exp2f(b.y);
        sum2 += pa; sum2 += pb;
        pp[i][0] = __builtin_bit_cast(unsigned, __builtin_convertvector(pa, bf16x2_t)); pp[i][1] = __builtin_bit_cast(unsigned, __builtin_convertvector(pb, bf16x2_t)); }
    float sum = sum2.x + sum2.y;
    if (MASKED) { pp[NT - 1][0] = 0u; pp[NT - 1][1] = 0u; }
    sum += __shfl_xor(sum, 16); sum += __shfl_xor(sum, 32);
    f32x4 oacc[8];
#pragma unroll
    for (int c = 0; c < 8; ++c) oacc[c] = (f32x4){0.f, 0.f, 0.f, 0.f};
    const int q4 = l15 >> 2, p4 = lane & 3; const int xv = (q4 << 2) | g;
    unsigned ldsb = (unsigned)(size_t)lds; asm volatile("" : "+v"(ldsb));
    unsigned voff[8];
#pragma unroll
    for (int c = 0; c < 8; ++c) voff[c] = 256 * (4 * g + q4) + 16 * ((2 * c + (p4 >> 1)) ^ xv) + 8 * (p4 & 1);
    constexpr int NG = NT;
    s16x4_t lo[2][4], hi[2][4];
#define A3_READS(i) do { const int s_ = (i) >> 1, ch_ = (i) & 1; const int ta_ = MASKED ? min(wave + 2 * s_, 15) : 2 * s_, tb_ = MASKED ? min(wave + 2 * s_ + 1, 15) : 2 * s_ + 1; \
        unsigned va_ = ldsb + A2_VOFF + A3_TILE(ta_, p), vb_ = ldsb + A2_VOFF + A3_TILE(tb_, p); asm volatile("" : "+v"(va_), "+v"(vb_)); \
        asm volatile("ds_read_b64_tr_b16 %0, %8\n\tds_read_b64_tr_b16 %1, %9\n\tds_read_b64_tr_b16 %2, %10\n\tds_read_b64_tr_b16 %3, %11\n\tds_read_b64_tr_b16 %4, %12\n\tds_read_b64_tr_b16 %5, %13\n\tds_read_b64_tr_b16 %6, %14\n\tds_read_b64_tr_b16 %7, %15" \
                     : "=&v"(lo[(i) & 1][0]), "=&v"(hi[(i) & 1][0]), "=&v"(lo[(i) & 1][1]), "=&v"(hi[(i) & 1][1]), "=&v"(lo[(i) & 1][2]), "=&v"(hi[(i) & 1][2]), "=&v"(lo[(i) & 1][3]), "=&v"(hi[(i) & 1][3]) \
                     : "v"(va_ + voff[4 * ch_ + 0]), "v"(vb_ + voff[4 * ch_ + 0]), "v"(va_ + voff[4 * ch_ + 1]), "v"(vb_ + voff[4 * ch_ + 1]), "v"(va_ + voff[4 * ch_ + 2]), "v"(vb_ + voff[4 * ch_ + 2]), "v"(va_ + voff[4 * ch_ + 3]), "v"(vb_ + voff[4 * ch_ + 3]) : "memory"); } while (0)
    A3_READS(0);
#pragma unroll
    for (int i = 0; i < NG; ++i) { __builtin_amdgcn_sched_barrier(0);
        if (i + 1 < NG) { A3_READS(i + 1);
            asm volatile("s_waitcnt lgkmcnt(8)" : "+v"(lo[i & 1][0]), "+v"(hi[i & 1][0]), "+v"(lo[i & 1][1]), "+v"(hi[i & 1][1]), "+v"(lo[i & 1][2]), "+v"(hi[i & 1][2]), "+v"(lo[i & 1][3]), "+v"(hi[i & 1][3]) :: "memory"); }
        else asm volatile("s_waitcnt lgkmcnt(0)" : "+v"(lo[i & 1][0]), "+v"(hi[i & 1][0]), "+v"(lo[i & 1][1]), "+v"(hi[i & 1][1]), "+v"(lo[i & 1][2]), "+v"(hi[i & 1][2]), "+v"(lo[i & 1][3]), "+v"(hi[i & 1][3]) :: "memory");
        const int s = i >> 1, ch = i & 1; const bf16x8_t pf = __builtin_bit_cast(bf16x8_t, (v4u){pp[2 * s][0], pp[2 * s][1], pp[2 * s + 1][0], pp[2 * s + 1][1]});
#pragma unroll
        for (int c = 0; c < 4; ++c) { const bf16x8_t vf = {lo[i & 1][c][0], lo[i & 1][c][1], lo[i & 1][c][2], lo[i & 1][c][3], hi[i & 1][c][0], hi[i & 1][c][1], hi[i & 1][c][2], hi[i & 1][c][3]};
            oacc[4 * ch + c] = __builtin_amdgcn_mfma_f32_16x16x32_bf16(vf, pf, oacc[4 * ch + c], 0, 0, 0); } }
#undef A3_READS
    const float inv = 1.0f / sum; bf16* op = B.o + (long)(wave * 16 + l15) * B.ostride + 4 * g;
#pragma unroll
    for (int c = 0; c < 8; ++c) { v2u w; w.x = pk2(oacc[c][0] * inv, oacc[c][1] * inv); w.y = pk2(oacc[c][2] * inv, oacc[c][3] * inv); *(v2u*)(op + 16 * c) = w; }
    if (MASKED && g == 0) B.lse[(long)(wave * 16 + l15) * B.lstride] = mx * ATT_SCALE + __logf(sum);
}
__device__ __forceinline__ void p2_attn_chain(const Args& a, LAS unsigned char* lds, int tid, int lane, int wave, int vcu, int G) {
    const int l15 = lane & 15, g = lane >> 4; constexpr int NITEM = 1792;
    int item = vcu, pos = 0; if (item >= NITEM) return;
    A3Blk D, Dn; a3_desc(a, item, pos, D);
    v4u qf[4]; f32x4 st[16];
    a3_stage<true>(lds, D.B.k, D, lane, wave); a2_loadq(qf, D.B.q, D.B.qstride, wave, l15, g);
    asm volatile("s_waitcnt vmcnt(0)" ::: "memory"); __builtin_amdgcn_s_barrier(); asm volatile("" ::: "memory");
    a3_stage<false>(lds + A2_VOFF, D.B.v, D, lane, wave);
    for (;;) {
        int itemn = item, posn = pos + 1; if (posn >= a3_chainlen(item)) { itemn = item + G; posn = 0; }
        const bool has_next = itemn < NITEM; if (has_next) a3_desc(a, itemn, posn, Dn);
        if (D.masked) a3_qk<true>(lds, qf, st, D.p, wave, l15, g); else a3_qk<false>(lds, qf, st, D.p, wave, l15, g);
        asm volatile("s_waitcnt vmcnt(0)" ::: "memory"); __builtin_amdgcn_s_barrier(); asm volatile("" ::: "memory");
        if (has_next) { a3_stage<true>(lds, Dn.B.k, Dn, lane, wave); a2_loadq(qf, Dn.B.q, Dn.B.qstride, wave, l15, g); }
        if (D.masked) { a3_softmax_pv<true>(lds, st, D.B, D.p, wave, lane, l15, g); asm volatile("s_waitcnt vmcnt(9)" ::: "memory"); }
        else { a3_softmax_pv<false>(lds, st, D.B, D.p, wave, lane, l15, g); asm volatile("s_waitcnt vmcnt(8)" ::: "memory"); }
        asm volatile("s_waitcnt lgkmcnt(0)" ::: "memory"); __builtin_amdgcn_s_barrier(); asm volatile("" ::: "memory");
        if (!has_next) break;
        a3_stage<false>(lds + A2_VOFF, Dn.B.v, Dn, lane, wave);
        D = Dn; item = itemn; pos = posn;
    }
    asm volatile("s_waitcnt vmcnt(0)" ::: "memory"); __builtin_amdgcn_s_barrier();
}
constexpr int SGU_P = 800, SGU_STAT = 128 * SGU_P;
__device__ __forceinline__ void sgu_unit_mfma(const Args& a, LAS unsigned char* lds, int unit, int tid, int lane, int wave) {
    const bf16* Z = (const bf16*)(a.ws + WS_Z); bf16* Y = (bf16*)(a.ws + WS_Y);
    const float* __restrict__ wsp = a.in[I_WSP]; const float* __restrict__ bsp = a.in[I_BSP]; const float* lng = a.in[I_ALNG]; const float* lnb = a.in[I_ALNB];
    const int tok0 = unit * 128;
    LAS float* stat = (LAS float*)(lds + SGU_STAT);
    {
        const int tk = wave * 16 + (lane >> 2); const v4u* vp = (const v4u*)(Z + (size_t)(tok0 + tk) * DPJ + ZV + (lane & 3) * 192); float s = 0.f, q = 0.f;
#pragma unroll
        for (int hf = 0; hf < 2; ++hf) { v4u w[12];
#pragma unroll
            for (int j = 0; j < 12; ++j) w[j] = vp[12 * hf + j];
#pragma unroll
            for (int j = 0; j < 12; ++j)
#pragma unroll
                for (int e = 0; e < 4; ++e) { const float x0 = bflo(w[j][e]), x1 = bfhi(w[j][e]); s += x0 + x1; q = fmaf(x0, x0, fmaf(x1, x1, q)); } }
        s += __shfl_xor(s, 1); s += __shfl_xor(s, 2); q += __shfl_xor(q, 1); q += __shfl_xor(q, 2);
        const float mean = s * (1.0f / 768.0f), rstd = 1.0f / sqrtf(fmaxf(q * (1.0f / 768.0f) - mean * mean, 0.f) + LN_EPS);
        if ((lane & 3) == 0) { stat[2 * tk] = mean; stat[2 * tk + 1] = rstd; } }
    __syncthreads();
    const int l15 = lane & 15, g4 = lane >> 4, q4 = l15 >> 2, p4 = lane & 3;
    const int t = wave * 16 + l15, ksmax = wave >> 1;
    float ss = 0.f; bf16* yo = Y + (size_t)(tok0 + t) * DM + 4 * g4;
#pragma unroll 1
    for (int r = 0; r < 2; ++r) {
#pragma unroll 1
        for (int ib = 0; ib < 24; ib += 8) { v2u zw[8]; f32x4 gv[8], bv[8];
#pragma unroll
            for (int j = 0; j < 8; ++j) { const int idx = tid + 512 * (ib + j), s = idx / 96, c4 = (idx - s * 96) * 4;
                zw[j] = *(const v2u*)(Z + (size_t)(tok0 + s) * DPJ + ZV + r * 384 + c4); gv[j] = *(const f32x4*)(lng + r * 384 + c4); bv[j] = *(const f32x4*)(lnb + r * 384 + c4); }
            asm volatile("" ::: "memory");
#pragma unroll
            for (int j = 0; j < 8; ++j) { const int idx = tid + 512 * (ib + j), s = idx / 96, c4 = (idx - s * 96) * 4;
                const v2u w = zw[j]; const float mean = stat[2 * s], rstd = stat[2 * s + 1]; const f32x4 gg = gv[j], bb = bv[j];
                v2u o; o.x = pk2((bflo(w.x) - mean) * rstd * gg[0] + bb[0], (bfhi(w.x) - mean) * rstd * gg[1] + bb[1]); o.y = pk2((bflo(w.y) - mean) * rstd * gg[2] + bb[2], (bfhi(w.y) - mean) * rstd * gg[3] + bb[3]);
                *(LAS v2u*)(lds + s * SGU_P + c4 * 2) = o; } }
        __syncthreads();
#pragma unroll 1
        for (int gi = 0; gi < 3; ++gi) { const int g = 3 * r + gi;
            f32x4 acc[8];
#pragma unroll
            for (int ct = 0; ct < 8; ++ct) acc[ct] = (f32x4){0.f, 0.f, 0.f, 0.f};
            const float* Wrow = wsp + (size_t)g * 16384 + t * 128 + 8 * g4;
            f32x4 wA[4], wB[4];
#pragma unroll
            for (int ks = 0; ks < 4; ++ks) { wA[ks] = (f32x4){0.f, 0.f, 0.f, 0.f}; wB[ks] = wA[ks]; if (ks <= ksmax) { wA[ks] = *(const f32x4*)(Wrow + 32 * ks); wB[ks] = *(const f32x4*)(Wrow + 32 * ks + 4); } }
            const bf16* up = Z + (size_t)(tok0 + t) * DPJ + ZU + g * 128 + 4 * g4; v2u uu8[8];
#pragma unroll
            for (int ct = 0; ct < 8; ++ct) uu8[ct] = *(const v2u*)(up + 16 * ct);
            const float bias = bsp[g * 128 + t];
#pragma unroll
            for (int ks = 0; ks < 4; ++ks) { if (ks <= ksmax) { const int s0 = 32 * ks + 8 * g4; const f32x4 wa = wA[ks], wb = wB[ks];
                v4u wp; wp.x = pk2(s0 <= t ? wa[0] : 0.f, s0 + 1 <= t ? wa[1] : 0.f); wp.y = pk2(s0 + 2 <= t ? wa[2] : 0.f, s0 + 3 <= t ? wa[3] : 0.f);
                wp.z = pk2(s0 + 4 <= t ? wb[0] : 0.f, s0 + 5 <= t ? wb[1] : 0.f); wp.w = pk2(s0 + 6 <= t ? wb[2] : 0.f, s0 + 7 <= t ? wb[3] : 0.f);
                const bf16x8_t wf = __builtin_bit_cast(bf16x8_t, wp);
                const LAS unsigned char* vp = lds + (32 * ks + 8 * g4 + q4) * SGU_P + gi * 256 + 8 * p4;
#pragma unroll
                for (int ct = 0; ct < 8; ++ct) { const s16x4_t lo = __builtin_bit_cast(s16x4_t, __builtin_amdgcn_ds_read_tr16_b64_v4i16((LAS s16x4_t*)(vp + 32 * ct))), hi = __builtin_bit_cast(s16x4_t, __builtin_amdgcn_ds_read_tr16_b64_v4i16((LAS s16x4_t*)(vp + 4 * SGU_P + 32 * ct)));
                    const bf16x8_t vf = {lo[0], lo[1], lo[2], lo[3], hi[0], hi[1], hi[2], hi[3]};
                    acc[ct] = __builtin_amdgcn_mfma_f32_16x16x32_bf16(vf, wf, acc[ct], 0, 0, 0); } } }
#pragma unroll
            for (int ct = 0; ct < 8; ++ct) { const v2u uu = uu8[ct];
                const float y0 = bflo(uu.x) * (acc[ct][0] + bias), y1 = bfhi(uu.x) * (acc[ct][1] + bias), y2 = bflo(uu.y) * (acc[ct][2] + bias), y3 = bfhi(uu.y) * (acc[ct][3] + bias);
                ss += (y0 * y0 + y1 * y1) + (y2 * y2 + y3 * y3); v2u yw; yw.x = pk2(y0, y1); yw.y = pk2(y2, y3); *(v2u*)(yo + g * 128 + 16 * ct) = yw; } }
        __syncthreads();
    }
    ss += __shfl_xor(ss, 16); ss += __shfl_xor(ss, 32);
    const float rs = 1.0f / sqrtf(ss * (1.0f / 768.0f) + LN_EPS);
    asm volatile("s_waitcnt vmcnt(0)" ::: "memory");
#pragma unroll 1
    for (int g2 = 0; g2 < 3; ++g2) { v2u yr[16];
#pragma unroll
        for (int i = 0; i < 16; ++i) yr[i] = *(const v2u*)(yo + (2 * g2 + (i >> 3)) * 128 + 16 * (i & 7));
        asm volatile("" ::: "memory");
#pragma unroll
        for (int i = 0; i < 16; ++i) { v2u w; w.x = pk2(bflo(yr[i].x) * rs, bfhi(yr[i].x) * rs); w.y = pk2(bflo(yr[i].y) * rs, bfhi(yr[i].y) * rs); *(v2u*)(yo + (2 * g2 + (i >> 3)) * 128 + 16 * (i & 7)) = w; } }
}
__device__ __forceinline__ void p5_ln1_router_wave(const Args& a, LAS unsigned char* lds, int tid, int lane, int wave, int vcu, int G, int probe) {
    const bf16* H1 = (const bf16*)(a.ws + WS_H1); unsigned char* X1Q = a.ws + WS_X1Q; unsigned* ctl = (unsigned*)(a.ws + WS_CTL);
    int* LIST = (int*)(a.ws + (probe ? WS_XS + 256 * MiB : WS_LIST)); float* GATEL = (float*)(a.ws + (probe ? WS_XS + 260 * MiB : WS_GATEL)); const int cwc = probe ? CW_CNT + 4096 : CW_CNT;
    float* STATS = (float*)(a.ws + WS_STATS); const bf16* WRB = (const bf16*)(a.ws + WS_WRF); const float* C12 = (const float*)(a.ws + WS_WRF + 512 * 1024); const bf16* GB16 = (const bf16*)(a.ws + WS_WRF + 768 * 1024);
    const int l15 = lane & 15, g4 = lane >> 4;
    LAS unsigned* cntl = (LAS unsigned*)lds; LAS unsigned* basel = cntl + 32;
    if (tid < 32) cntl[tid] = 0u;
    asm volatile("s_waitcnt lgkmcnt(0)" ::: "memory"); __builtin_amdgcn_s_barrier(); asm volatile("" ::: "memory");
    constexpr int P5_GB = 1024 + 131072;
    { const v4u* gsrc = (const v4u*)GB16; for (int u = tid; u < 512; u += NWAVES * 64) *(LAS v4u*)(lds + P5_GB + 16 * u) = gsrc[u]; }
    for (int wgt = vcu; wgt < NTOK / 128; wgt += G) { const int grp = wgt * NWAVES + wave; const int row0 = grp * 16;
        const bf16* hp = H1 + (size_t)(row0 + l15) * DM + 8 * g4; const bf16* wp = WRB + lane * 8;
        f32x4 acc0 = {0.f, 0.f, 0.f, 0.f}, acc1 = {0.f, 0.f, 0.f, 0.f}; float s1 = 0.f, s2 = 0.f;
        constexpr int P5_WB = 1024;
#define P5_STAGE(C_, BUF_) do { _Pragma("unroll") for (int i_ = 0; i_ < 8; ++i_) __builtin_amdgcn_global_load_lds((const unsigned*)((const unsigned char*)WRB + (size_t)(C_) * 65536 + (wave * 8 + i_) * 1024 + lane * 16), \
            (LAS unsigned*)(lds + P5_WB + (BUF_) * 65536 + (wave * 8 + i_) * 1024), 16, 0, 0); } while (0)
#define P5_LOADH(C_, HALF_, H) do { _Pragma("unroll") for (int i_ = 0; i_ < 8; ++i_) H[i_] = *(const v4u*)(hp + 32 * (16 * (C_) + 8 * (HALF_) + i_)); } while (0)
#define P5_HALF(BUF_, HALF_, H) do { unsigned wl_ = (unsigned)(size_t)(lds + P5_WB + (BUF_) * 65536 + (HALF_) * 32768) + lane * 16; \
        _Pragma("unroll") for (int i_ = 0; i_ < 8; ++i_) { const v4u hw = H[i_]; v4u w0h, w0l, w1h, w1l; \
            asm volatile("ds_read_b128 %0, %4\n\tds_read_b128 %1, %4 offset:1024\n\tds_read_b128 %2, %4 offset:2048\n\tds_read_b128 %3, %4 offset:3072\n\ts_waitcnt lgkmcnt(0)" \
                         : "=&v"(w0h), "=&v"(w0l), "=&v"(w1h), "=&v"(w1l) : "v"(wl_ + i_ * 4096) : "memory");       \
            const bf16x8_t af = __builtin_bit_cast(bf16x8_t, hw); \
            acc0 = __builtin_amdgcn_mfma_f32_16x16x32_bf16(af, __builtin_bit_cast(bf16x8_t, w0h), acc0, 0, 0, 0); acc0 = __builtin_amdgcn_mfma_f32_16x16x32_bf16(af, __builtin_bit_cast(bf16x8_t, w0l), acc0, 0, 0, 0); \
            acc1 = __builtin_amdgcn_mfma_f32_16x16x32_bf16(af, __builtin_bit_cast(bf16x8_t, w1h), acc1, 0, 0, 0); acc1 = __builtin_amdgcn_mfma_f32_16x16x32_bf16(af, __builtin_bit_cast(bf16x8_t, w1l), acc1, 0, 0, 0); \
            _Pragma("unroll") for (int q = 0; q < 4; ++q) { const float x0 = bflo(hw[q]), x1 = bfhi(hw[q]); s1 += x0 + x1; s2 = fmaf(x0, x0, fmaf(x1, x1, s2)); } } } while (0)
#define P5_BAR() do { asm volatile("" ::: "memory"); __builtin_amdgcn_s_barrier(); asm volatile("" ::: "memory"); } while (0)
#define P5_F() asm volatile("" ::: "memory")
        { v4u hA[8], hB[8];
          P5_STAGE(0, 0); P5_STAGE(1, 1); P5_LOADH(0, 0, hA);
          asm volatile("s_waitcnt vmcnt(0)" ::: "memory"); P5_BAR();
          P5_LOADH(0, 1, hB); P5_F(); P5_HALF(0, 0, hA); P5_LOADH(1, 0, hA); P5_F(); P5_HALF(0, 1, hB);
          P5_BAR(); P5_STAGE(2, 0);
          P5_LOADH(1, 1, hB); P5_F(); P5_HALF(1, 0, hA); P5_LOADH(2, 0, hA); P5_F(); P5_HALF(1, 1, hB);
          P5_BAR(); P5_STAGE(3, 1);
          asm volatile("s_waitcnt vmcnt(8)" ::: "memory"); P5_BAR();
          P5_LOADH(2, 1, hB); P5_F(); P5_HALF(0, 0, hA); P5_LOADH(3, 0, hA); P5_F(); P5_HALF(0, 1, hB);
          asm volatile("s_waitcnt vmcnt(0)" ::: "memory"); P5_BAR();
          P5_LOADH(3, 1, hB); P5_F(); P5_HALF(1, 0, hA); P5_HALF(1, 1, hB);
          P5_BAR(); }
#undef P5_F
#undef P5_HALF
#undef P5_STAGE
#undef P5_LOADH
#undef P5_BAR
        s1 += __shfl_xor(s1, 16); s1 += __shfl_xor(s1, 32); s2 += __shfl_xor(s2, 16); s2 += __shfl_xor(s2, 32);
        const float mean = s1 * (1.0f / DM), rstd = 1.0f / sqrtf(fmaxf(s2 * (1.0f / DM) - mean * mean, 0.f) + LN_EPS);
        const float c1a = C12[l15], c1b = C12[16 + l15], c2a = C12[32 + l15], c2b = C12[48 + l15];
        float va[4], vb[4];
#pragma unroll
        for (int j = 0; j < 4; ++j) { const float mj = __shfl(mean, 4 * g4 + j), rj = __shfl(rstd, 4 * g4 + j); va[j] = rj * (acc0[j] - mj * c1a) + c2a; vb[j] = rj * (acc1[j] - mj * c1b) + c2b; }
        float tv[4][4]; int ti[4][4];
#pragma unroll
        for (int r = 0; r < 4; ++r)
#pragma unroll
            for (int j = 0; j < 4; ++j) { float bv = va[j]; int bi = l15; if (vb[j] > bv) { bv = vb[j]; bi = 16 + l15; }
#pragma unroll
                for (int o = 1; o < 16; o <<= 1) { const float ov = __shfl_xor(bv, o); const int oi = __shfl_xor(bi, o); if (ov > bv || (ov == bv && oi < bi)) { bv = ov; bi = oi; } }
                tv[r][j] = bv; ti[r][j] = bi; if (bi == l15) va[j] = -INFINITY; if (bi == 16 + l15) vb[j] = -INFINITY; }
        int mye[4]; float myg[4]; unsigned myr[4];
#pragma unroll
        for (int j = 0; j < 4; ++j) { const float e1 = __expf(tv[1][j] - tv[0][j]), e2 = __expf(tv[2][j] - tv[0][j]), e3 = __expf(tv[3][j] - tv[0][j]); const float inv = 1.0f / (1.0f + e1 + e2 + e3);
            mye[j] = l15 == 0 ? ti[0][j] : (l15 == 1 ? ti[1][j] : (l15 == 2 ? ti[2][j] : ti[3][j])); myg[j] = (l15 == 0 ? 1.0f : (l15 == 1 ? e1 : (l15 == 2 ? e2 : e3))) * inv; myr[j] = 0u;
            if (l15 < 4) myr[j] = __hip_atomic_fetch_add(cntl + mye[j], 1u, __ATOMIC_RELAXED, __HIP_MEMORY_SCOPE_WORKGROUP); }
        asm volatile("s_waitcnt lgkmcnt(0)" ::: "memory"); __builtin_amdgcn_s_barrier(); asm volatile("" ::: "memory");
        if (tid < 32) { const unsigned n = cntl[tid]; basel[tid] = n ? atomicAdd(ctl + cwc + 64 * tid, n) : 0u; }
        asm volatile("s_waitcnt vmcnt(0) lgkmcnt(0)" ::: "memory"); __builtin_amdgcn_s_barrier(); asm volatile("" ::: "memory");
        if (l15 < 4) {
#pragma unroll
            for (int j = 0; j < 4; ++j) { const int row = row0 + 4 * g4 + j; const unsigned rank = basel[mye[j]] + myr[j]; LIST[(size_t)mye[j] * NTOK + rank] = row * 4 + l15; GATEL[(size_t)mye[j] * NTOK + rank] = myg[j]; } }
        asm volatile("s_waitcnt lgkmcnt(0)" ::: "memory"); __builtin_amdgcn_s_barrier(); asm volatile("" ::: "memory");
        if (tid < 32) cntl[tid] = 0u;
        asm volatile("s_waitcnt lgkmcnt(0)" ::: "memory"); __builtin_amdgcn_s_barrier(); asm volatile("" ::: "memory");
        if (g4 == 0) { STATS[2 * (row0 + l15)] = mean; STATS[2 * (row0 + l15) + 1] = rstd; }
        unsigned char* xo = X1Q + (size_t)(row0 + l15) * DM + 8 * g4; const float rs8 = rstd * XS_SCALE; const LAS unsigned char* gpl = lds + P5_GB + 16 * g4;
#pragma unroll 1
        for (int sb = 0; sb < 4; ++sb) { v4u hq[16];
#pragma unroll
            for (int i = 0; i < 16; ++i) hq[i] = *(const v4u*)(hp + 32 * (16 * sb + i));
#pragma unroll
            for (int i = 0; i < 16; ++i) { const int s = 16 * sb + i; const v4u hw = hq[i], gg = *(const LAS v4u*)(gpl + 64 * s), bb = *(const LAS v4u*)(gpl + 4096 + 64 * s);
                v2u o; o.x = pk4_fp8((bflo(hw.x) - mean) * rs8 * bflo(gg.x) + bflo(bb.x), (bfhi(hw.x) - mean) * rs8 * bfhi(gg.x) + bfhi(bb.x), (bflo(hw.y) - mean) * rs8 * bflo(gg.y) + bflo(bb.y), (bfhi(hw.y) - mean) * rs8 * bfhi(gg.y) + bfhi(bb.y));
                o.y = pk4_fp8((bflo(hw.z) - mean) * rs8 * bflo(gg.z) + bflo(bb.z), (bfhi(hw.z) - mean) * rs8 * bfhi(gg.z) + bfhi(bb.z), (bflo(hw.w) - mean) * rs8 * bflo(gg.w) + bflo(bb.w), (bfhi(hw.w) - mean) * rs8 * bfhi(gg.w) + bfhi(bb.w));
                *(v2u*)(xo + 32 * s) = o; } }
    }
}
constexpr int NPHASE = 10;
__global__ void __launch_bounds__(NWAVES * 64, 2) fwd_kernel(Args args) {
    extern __shared__ __attribute__((aligned(16))) unsigned char lds_raw[];
    LAS unsigned char* lds = (LAS unsigned char*)lds_raw;
#define FRESH_IDS() int tid = threadIdx.x; asm volatile("" : "+v"(tid)); const int lane = tid & 63, wave = __builtin_amdgcn_readfirstlane(tid >> 6)
    const int G = gridDim.x; const int bx = blockIdx.x; const int vcu = (G % 8 == 0) ? (bx % 8) * (G / 8) + bx / 8 : bx;
    unsigned char* ws = args.ws;
    volatile LAS unsigned* MISC = (volatile LAS unsigned*)(lds + LDSCTL_OFF);
    LAS int* tb = (LAS int*)(lds + LDSCTL_OFF + 64); LAS int* cn = (LAS int*)(lds + LDSCTL_OFF + 256);
    { FRESH_IDS(); (void)lane; (void)wave; for (int u = tid; u < 128; u += NWAVES * 64) ((LAS unsigned*)(lds + LDSCTL_OFF))[u] = 0u; }
    __syncthreads();
#if ONE_LAUNCH
    XcdBarrier bar = xcd_barrier_post((unsigned*)(ws + WS_CTL) + CW_BAR, MISC);
#define GRID_BAR() xcd_barrier(bar)
#else
#define GRID_BAR() do {} while (0)
#endif
    const int lo = args.ph_lo, hi = args.ph_hi;
#define IN(k) (lo <= (k) && (k) < hi)
#define BOTH(k) (IN(k) && IN((k) + 1))
    if (IN(0)) { FRESH_IDS(); p0_prep(args, lds, tid, lane, wave, vcu, G); moe_conv_lds(args, lds, lane, wave, vcu * NWAVES + wave, G * NWAVES); if (BOTH(0)) GRID_BAR(); }
    if (IN(1)) {
        {
        { pg8::Gemm g{(const pg8::bf16_t*)(ws + WS_XB), (const pg8::bf16_t*)(ws + WS_WINT), NTOK, DPJ, DM}; pg8::StaticOrder S; S.init(NTOK, DPJ, G, bx);
          pg8::EpiZ E{(pg8::bf16_t*)(ws + WS_Z), DPJ, 6};
          pg8::gemm_phase<pg8::EpiZ, pg8::StaticOrder, true, BF16_SP2>(lds, g, S, E); }
        { pg8::Gemm g{(const pg8::bf16_t*)(ws + WS_MEMB), (const pg8::bf16_t*)(ws + WS_WMKVT), 2048, 1024, DM}; pg8::StaticOrder S; S.init(2048, 1024, G, (bx + G - MKV_SHIFT) % G);
          pg8::EpiZ E{(pg8::bf16_t*)(ws + WS_MKV), 1024, 0};
          pg8::gemm_phase<pg8::EpiZ, pg8::StaticOrder, true, BF16_SP2>(lds, g, S, E); }
        }
        if (BOTH(1)) GRID_BAR();
    }
    if (IN(2)) { FRESH_IDS();
        for (int u = vcu; u < NTOK / 128; u += G) sgu_unit_mfma(args, lds, u, tid, lane, wave);
        p2_attn_chain(args, lds, tid, lane, wave, vcu, G);
        if (BOTH(2)) GRID_BAR(); }
    if (IN(3)) { FRESH_IDS(); (void)tid;
        p2b_combine(args, lane, wave, vcu, G);
        if (BOTH(3)) GRID_BAR(); }
    if (IN(4)) {
        pg8::Gemm g{(const pg8::bf16_t*)(ws + WS_Y), (const pg8::bf16_t*)(ws + WS_WOUTT), NTOK, DM, DM}; pg8::StaticOrder S; S.init(NTOK, DM, G, bx);
        pg8::EpiRes E{(const pg8::bf16_t*)(ws + WS_XB), (pg8::bf16_t*)(ws + WS_H1), DM, DN_ALPHA};
        pg8::gemm_phase<pg8::EpiRes, pg8::StaticOrder, true, BF16_SP2>(lds, g, S, E);
        if (BOTH(4)) GRID_BAR();
    }
    if (IN(5)) { FRESH_IDS(); p5_ln1_router_wave(args, lds, tid, lane, wave, vcu, G, 0); if (BOTH(5)) GRID_BAR(); }
    if (IN(6)) { FRESH_IDS(); (void)lane; (void)wave; moe_table(args, tb, cn, tid); p6_tables(args, tb, cn, tid, vcu, G); if (BOTH(6)) GRID_BAR(); }
    if (IN(7)) {
        { FRESH_IDS(); (void)lane; (void)wave; moe_table(args, tb, cn, tid); }
        pg8::Gemm g{(const pg8::bf16_t*)(ws + WS_X1Q), (const pg8::bf16_t*)(ws + WS_WGUT), NTOK, NEXP * 4096, DM / 2};
        pg8::MoeOrder S{(const PG8_LAS int*)tb, 4, G, bx, tb[32] * 16, 0, lds + UTAB_OFF, (const char*)(ws + WS_ROWOFF), args.in[I_BGU]};
        pg8::EpiGU E{ws + WS_ACT, args.in[I_BGU], 1.0f / (W_SCALE * XS_SCALE), ACT_SCALE};
        pg8::gemm_phase_ut<pg8::EpiGU, pg8::MoeOrder, true>(lds, g, S, E);
        if (BOTH(7)) GRID_BAR();
    }
    if (IN(8)) {
        { FRESH_IDS(); (void)lane; (void)wave; moe_table(args, tb, cn, tid); }
        pg8::Gemm g{(const pg8::bf16_t*)(ws + WS_ACT), (const pg8::bf16_t*)(ws + WS_WDT), MAXROWS, NEXP * 2048, DM / 2};
        pg8::MoeOrder S{(const PG8_LAS int*)tb, 3, G, bx, tb[32] * 8, 0, lds + UTAB_OFF, (const char*)(ws + WS_ROWGATE), args.in[I_BD]};
        pg8::EpiDown E{ws + WS_YS, args.in[I_BD], (const float*)(ws + WS_ROWGATE), 1.0f / (W_SCALE * ACT_SCALE), YS_SCALE};
        pg8::gemm_phase_ut<pg8::EpiDown, pg8::MoeOrder, false>(lds, g, S, E);
        if (BOTH(8)) GRID_BAR();
    }
    if (IN(9)) { FRESH_IDS(); p8_final(args, lds, tid, lane, wave, vcu, G); }
#undef IN
#undef BOTH
}

extern "C" void kernel_launch(void* const* d_in, const int* in_sizes, int n_in, void* d_out, int out_size, void* d_ws, size_t ws_size, hipStream_t stream) {
    static int grid = 0;
    if (grid == 0) {
        if (n_in != 22 || in_sizes[0] != NTOK * DM || out_size != NTOK * DM || ws_size < WS_END) { fprintf(stderr, "kernel_launch: unexpected shapes (n_in %d, in0 %d, out %d, ws %zu < %zu)\n", n_in, n_in > 0 ? in_sizes[0] : -1, out_size, ws_size, (size_t)WS_END); grid = -1; return; }
        int dev = 0, cus = 0, per_cu = 0;
        if (hipGetDevice(&dev) != hipSuccess || hipDeviceGetAttribute(&cus, hipDeviceAttributeMultiprocessorCount, dev) != hipSuccess) { grid = -1; return; }
        if (hipFuncSetAttribute((const void*)fwd_kernel, hipFuncAttributeMaxDynamicSharedMemorySize, LDS_BYTES) != hipSuccess) { fprintf(stderr, "kernel_launch: hipFuncSetAttribute failed\n"); grid = -1; return; }
        if (hipOccupancyMaxActiveBlocksPerMultiprocessor(&per_cu, (const void*)fwd_kernel, NWAVES * 64, LDS_BYTES) != hipSuccess || per_cu < 1) fprintf(stderr, "kernel_launch: occupancy query reports %d\n", per_cu);
        (void)hipGetLastError();
        grid = cus;
    }
    if (grid < 0) return;
    if (hipMemsetAsync((char*)d_ws + WS_CTL, 0, CTL_ZERO_BYTES, stream) != hipSuccess) return;
    Args a{};
    for (int i = 0; i < 22; ++i) a.in[i] = (const float*)d_in[i];
    a.out = (float*)d_out; a.ws = (unsigned char*)d_ws;
#if ONE_LAUNCH
    a.ph_lo = 0; a.ph_hi = NPHASE;
    hipLaunchKernelGGL(fwd_kernel, dim3(grid), dim3(NWAVES * 64), LDS_BYTES, stream, a);
#else
    for (int p = 0; p < NPHASE; ++p) { a.ph_lo = p; a.ph_hi = p + 1; hipLaunchKernelGGL(fwd_kernel, dim3(grid), dim3(NWAVES * 64), LDS_BYTES, stream, a); }
#endif
}
```
